# Optimizing an MI355X kernel written in HIP

```python
import jax, jax.numpy as jnp
from jax import lax
import numpy as np

D_MODEL = 1024
BATCH = 4
SEQ = 8192
DEPTH = 1

CHUNK = 64
N_LEFT_CHUNKS = 8
BAND = (N_LEFT_CHUNKS + 1) * CHUNK
REL_CLIP = 256
D_MIX = D_MODEL
HEAD_DIM = 64
D_RWKV = D_MIX // 2
D_ATTN = D_MIX - D_RWKV
H_RWKV = D_RWKV // HEAD_DIM
H_ATTN = D_ATTN // HEAD_DIM
DECAY_LORA = 64
AAA_LORA = 64
GATE_LORA = 128
D_FF = ((8 * D_MODEL // 3 + 127) // 128) * 128
N_RWKV_COLS = 3 * D_RWKV + DECAY_LORA + AAA_LORA + GATE_LORA
N_IN_COLS = N_RWKV_COLS + 3 * D_ATTN
N_MOD = 9
NORM_EPS = 1e-6
QK_EPS = 1e-6
LNX_EPS = 64e-5

kernel_name = "hybrid_rwkv7_chunkattn_macaron_adaln"


def rms_norm(x, g, eps):
    xf = x.astype(jnp.float32)
    y = xf * lax.rsqrt(jnp.mean(xf * xf, axis=-1, keepdims=True) + eps)
    return (y * g.astype(jnp.float32)).astype(x.dtype)


def modulate(n, shift, scale):
    return n * (1 + scale[:, None, :]) + shift[:, None, :]


def swiglu(n, w1, w3, w2):
    return (jax.nn.silu(n @ w1) * (n @ w3)) @ w2


def rwkv7_scan(r, w, k, v, kk, b):
    def step(state, inp):
        r_t, w_t, k_t, v_t, kk_t, b_t = inp
        sa = jnp.einsum('bhvk,bhk->bhv', state, -kk_t)
        state = (state * w_t[:, :, None, :] + sa[..., None] * b_t[:, :, None, :]
                 + v_t[..., None] * k_t[:, :, None, :])
        y_t = jnp.einsum('bhvk,bhk->bhv', state, r_t)
        return state, y_t

    bsz, _, nh, hd = r.shape
    seq_first = tuple(jnp.moveaxis(a, 1, 0) for a in (r, w, k, v, kk, b))
    state0 = jnp.zeros((bsz, nh, hd, hd), jnp.float32)
    _, ys = lax.scan(step, state0, seq_first)
    return jnp.moveaxis(ys, 0, 1)


def rwkv7_mixer(p, mu, w0, w_decay_up, a0, w_a_up, w_g_up, k_k, k_a, r_k, lnx_g, lnx_b):
    bsz, seq, _ = p.shape
    p = p.astype(jnp.float32)
    p_prev = jnp.pad(p[:, :-1], ((0, 0), (1, 0), (0, 0)))
    p = p + (p_prev - p) * mu.astype(jnp.float32)
    o = 3 * D_RWKV
    r, k, v = p[..., :D_RWKV], p[..., D_RWKV:2 * D_RWKV], p[..., 2 * D_RWKV:o]
    wd = p[..., o:o + DECAY_LORA]
    ad = p[..., o + DECAY_LORA:o + DECAY_LORA + AAA_LORA]
    gd = p[..., o + DECAY_LORA + AAA_LORA:]
    f32 = lambda t: t.astype(jnp.float32)
    w_pre = -jax.nn.softplus(-(f32(w0) + jnp.tanh(wd) @ f32(w_decay_up))) - 0.5
    decay = jnp.exp(-jnp.exp(w_pre))
    a = jax.nn.sigmoid(f32(a0) + ad @ f32(w_a_up))
    g = jax.nn.sigmoid(gd) @ f32(w_g_up)
    heads = lambda t: t.reshape(bsz, seq, H_RWKV, HEAD_DIM)
    kk = heads(k * f32(k_k))
    kk = kk / jnp.maximum(jnp.linalg.norm(kk, axis=-1, keepdims=True), 1e-12)
    k = k * (1 + (a - 1) * f32(k_a))
    r_h, k_h, v_h, a_h, w_h = heads(r), heads(k), heads(v), heads(a), heads(decay)
    y = rwkv7_scan(r_h, w_h, k_h, v_h, kk, kk * a_h)
    mean = jnp.mean(y, axis=-1, keepdims=True)
    var = jnp.mean(jnp.square(y - mean), axis=-1, keepdims=True)
    gn_g = f32(lnx_g).reshape(H_RWKV, HEAD_DIM)
    gn_b = f32(lnx_b).reshape(H_RWKV, HEAD_DIM)
    y = (y - mean) * lax.rsqrt(var + LNX_EPS) * gn_g + gn_b
    bonus = jnp.sum(r_h * k_h * f32(r_k), axis=-1, keepdims=True) * v_h
    return ((y + bonus).reshape(bsz, seq, D_RWKV) * g)


def chunk_band_attention(q, k, v, q_norm_g, k_norm_g, rel_bias):
    bsz, seq, _ = q.shape
    nc = seq // CHUNK
    to_chunks = lambda t: t.reshape(bsz, nc, CHUNK, H_ATTN, HEAD_DIM).transpose(0, 3, 1, 2, 4)
    q = rms_norm(to_chunks(q), q_norm_g, QK_EPS)
    k = rms_norm(to_chunks(k), k_norm_g, QK_EPS)
    v = to_chunks(v)
    padw = ((0, 0), (0, 0), (N_LEFT_CHUNKS, 0), (0, 0), (0, 0))
    k_pad, v_pad = jnp.pad(k, padw), jnp.pad(v, padw)
    k_band = jnp.concatenate([k_pad[:, :, j:j + nc] for j in range(N_LEFT_CHUNKS + 1)], axis=3)
    v_band = jnp.concatenate([v_pad[:, :, j:j + nc] for j in range(N_LEFT_CHUNKS + 1)], axis=3)
    band_j = np.repeat(np.arange(N_LEFT_CHUNKS + 1), CHUNK)
    kj = np.tile(np.arange(CHUNK), N_LEFT_CHUNKS + 1)
    qi = np.arange(CHUNK)[:, None]
    dist = (N_LEFT_CHUNKS - band_j)[None, :] * CHUNK + qi - kj[None, :]
    rel_idx = np.clip(dist, -REL_CLIP, REL_CLIP) + REL_CLIP
    bias = rel_bias[:, rel_idx].astype(jnp.float32)
    valid = (np.arange(nc)[:, None] - N_LEFT_CHUNKS + band_j[None, :]) >= 0
    scores = jnp.einsum('bhcqd,bhckd->bhcqk', q, k_band).astype(jnp.float32) * (HEAD_DIM ** -0.5)
    scores = scores + bias[None, :, None]
    scores = jnp.where(valid[None, None, :, None, :], scores, jnp.finfo(jnp.float32).min)
    probs = jax.nn.softmax(scores, axis=-1).astype(v.dtype)
    out = jnp.einsum('bhcqk,bhckd->bhcqd', probs, v_band)
    return out.transpose(0, 2, 3, 1, 4).reshape(bsz, seq, D_ATTN)


def setup_inputs(seed: int = 0) -> dict:
    key = jax.random.key(seed)
    ks = iter(jax.random.split(key, 32))
    L = DEPTH
    nrm = lambda shape, s: jax.random.normal(next(ks), shape, jnp.float32) * s
    gain = lambda shape: 1.0 + nrm(shape, 0.02)
    return {
        "x": nrm((BATCH, SEQ, D_MODEL), 1.0),
        "c": nrm((BATCH, D_MODEL), 1.0),
        "w_ada": nrm((L, D_MODEL, N_MOD * D_MODEL), D_MODEL ** -0.5),
        "b_ada": nrm((L, N_MOD * D_MODEL), 0.02),
        "norm1_g": gain((L, D_MODEL)),
        "ffn1_w1": nrm((L, D_MODEL, D_FF), D_MODEL ** -0.5),
        "ffn1_w3": nrm((L, D_MODEL, D_FF), D_MODEL ** -0.5),
        "ffn1_w2": nrm((L, D_FF, D_MODEL), D_FF ** -0.5),
        "norm2_g": gain((L, D_MODEL)),
        "w_in": nrm((L, D_MODEL, N_IN_COLS), D_MODEL ** -0.5),
        "mu_shift": jax.random.uniform(next(ks), (L, N_RWKV_COLS), jnp.float32),
        "w0": -2.0 + nrm((L, D_RWKV), 1.0),
        "w_decay_up": nrm((L, DECAY_LORA, D_RWKV), 0.5 * DECAY_LORA ** -0.5),
        "a0": nrm((L, D_RWKV), 0.1),
        "w_a_up": nrm((L, AAA_LORA, D_RWKV), AAA_LORA ** -0.5),
        "w_g_up": nrm((L, GATE_LORA, D_RWKV), GATE_LORA ** -0.5),
        "k_k": 0.85 + nrm((L, D_RWKV), 0.05),
        "k_a": 1.0 + nrm((L, D_RWKV), 0.05),
        "r_k": nrm((L, H_RWKV, HEAD_DIM), 0.1),
        "lnx_g": gain((L, D_RWKV)),
        "lnx_b": nrm((L, D_RWKV), 0.01),
        "q_norm_g": gain((L, HEAD_DIM)),
        "k_norm_g": gain((L, HEAD_DIM)),
        "rel_bias": nrm((L, H_ATTN, 2 * REL_CLIP + 1), 0.1),
        "w_out": nrm((L, D_MIX, D_MODEL), D_MIX ** -0.5),
        "norm3_g": gain((L, D_MODEL)),
        "ffn2_w1": nrm((L, D_MODEL, D_FF), D_MODEL ** -0.5),
        "ffn2_w3": nrm((L, D_MODEL, D_FF), D_MODEL ** -0.5),
        "ffn2_w2": nrm((L, D_FF, D_MODEL), D_FF ** -0.5),
    }


def reference(x, c, w_ada, b_ada, norm1_g, ffn1_w1, ffn1_w3, ffn1_w2, norm2_g, w_in,
              mu_shift, w0, w_decay_up, a0, w_a_up, w_g_up, k_k, k_a, r_k, lnx_g, lnx_b,
              q_norm_g, k_norm_g, rel_bias, w_out, norm3_g, ffn2_w1, ffn2_w3, ffn2_w2):
    bsz = x.shape[0]
    h = x
    for l in range(DEPTH):
        mod = (jax.nn.silu(c) @ w_ada[l] + b_ada[l]).reshape(bsz, N_MOD, D_MODEL)
        sh1, sc1, g1, sh2, sc2, g2, sh3, sc3, g3 = [mod[:, i] for i in range(N_MOD)]
        n1 = modulate(rms_norm(h, norm1_g[l], NORM_EPS), sh1, sc1)
        h = h + 0.5 * g1[:, None, :] * swiglu(n1, ffn1_w1[l], ffn1_w3[l], ffn1_w2[l])
        n2 = modulate(rms_norm(h, norm2_g[l], NORM_EPS), sh2, sc2)
        proj = n2 @ w_in[l]
        y_rwkv = rwkv7_mixer(proj[..., :N_RWKV_COLS], mu_shift[l], w0[l], w_decay_up[l],
                             a0[l], w_a_up[l], w_g_up[l], k_k[l], k_a[l], r_k[l],
                             lnx_g[l], lnx_b[l]).astype(h.dtype)
        o = N_RWKV_COLS
        y_attn = chunk_band_attention(proj[..., o:o + D_ATTN], proj[..., o + D_ATTN:o + 2 * D_ATTN],
                                      proj[..., o + 2 * D_ATTN:], q_norm_g[l], k_norm_g[l],
                                      rel_bias[l]).astype(h.dtype)
        mixed = jnp.concatenate([y_rwkv, y_attn], axis=-1) @ w_out[l]
        h = h + g2[:, None, :] * mixed
        n3 = modulate(rms_norm(h, norm3_g[l], NORM_EPS), sh3, sc3)
        h = h + 0.5 * g3[:, None, :] * swiglu(n3, ffn2_w1[l], ffn2_w3[l], ffn2_w2[l])
    return h
```

```cpp
#include <hip/hip_runtime.h>
#include <hip/hip_cooperative_groups.h>
#include <cstdio>
#include <cstdint>
namespace cg = cooperative_groups;
__device__ __forceinline__ int lane_now() { int l; asm volatile("v_mbcnt_lo_u32_b32 %0, -1, 0\n\tv_mbcnt_hi_u32_b32 %0, -1, %0" : "=v"(l)); return l; }
namespace pg8 {
#define PG8_LAS __attribute__((address_space(3)))
typedef unsigned short bf16_t;
typedef short bf16x8 __attribute__((ext_vector_type(8)));
typedef float f32x4 __attribute__((ext_vector_type(4)));
typedef unsigned u32x4 __attribute__((ext_vector_type(4)));
constexpr int BM = 256, BK = 64, HALF = 128, HTB = HALF * BK * 2  , STAGE_BYTES = 8 * HTB, NXCD = 8, WGM = 8;

__host__ __device__ __forceinline__ int lds_byte(int r, int c) { const int st = (r >> 4) * 2 + (c >> 5), rr = r & 15, cc = c & 31, ob = rr * 64 + cc * 2; return st * 1024 + (ob ^ (((ob >> 9) & 1) << 5)); }
__host__ __device__ __forceinline__ void stage_rc(int b, int& R, int& C) { const int st = b / 1024, sb = b % 1024, swz = sb ^ (((sb >> 9) & 1) << 5); R = (st >> 1) * 16 + swz / 64; C = (st & 1) * 32 + (swz % 64) / 2; }
__host__ __device__ __forceinline__ int perm32(int rho) { const int n = rho >> 4, i = rho & 15; return 8 * (i >> 2) + 4 * n + (i & 3); }

struct Unit { int pm, pn; };
struct Gemm { const bf16_t* A; const bf16_t* Bt; int M, N, K; };

struct StaticOrder {
    int nM, nN, nwg, G, c;
    __host__ __device__ void init(int M, int N, int G_, int c_) { nM = M / BM; nN = N / BM; nwg = nM * nN; G = G_; c = c_; }
    __host__ __device__ bool next(int i, Unit& u) const {
        const long L = (long)i * G + c; if (L >= nwg) return false;
        int wgid = (int)L; { const int q = nwg / NXCD, r = nwg % NXCD, xcd = wgid % NXCD, off = wgid / NXCD; wgid = (xcd < r ? xcd * (q + 1) : r * (q + 1) + (xcd - r) * q) + off; }
        const int nig = WGM * nN, gid = wgid / nig, fm = gid * WGM, gsz = (nM - fm) < WGM ? (nM - fm) : WGM;
        u.pm = fm + ((wgid % nig) % gsz); u.pn = (wgid % nig) / gsz; return true;
    }
    __device__ __forceinline__ void a_ready(const Unit&) const {}
    __device__ __forceinline__ void done(const Unit&) const {}
};

__device__ __forceinline__ unsigned cvt_pk_bf16(float lo, float hi) { unsigned r; asm volatile("v_cvt_pk_bf16_f32 %0, %1, %2" : "=v"(r) : "v"(lo), "v"(hi)); return r; }
typedef float f32x2 __attribute__((ext_vector_type(2)));
template <class Epi, class Sched, bool ALIGN_EPI = false, bool SP2 = false>
__device__ __forceinline__ void gemm_phase(PG8_LAS unsigned char* lds, const Gemm g, const Sched& S, const Epi& E, const int wid) {
    const int lane = lane_now(), tid = wid * 64 + lane, wr = wid >> 2, wc = wid & 3, fr = lane & 15, fq = lane >> 4;
    const int K = g.K, nt = K / BK;
    unsigned voffA[2], voffB[2];
#pragma unroll
    for (int i = 0; i < 2; ++i) { int R, C; stage_rc(tid * 16 + i * 8192, R, C); const int Rb = Epi::PERM ? ((R & ~31) + perm32(R & 31)) : R;
        voffA[i] = (unsigned)(R * K + C) * 2u; voffB[i] = (unsigned)(Rb * K + C) * 2u; }
    const size_t kstep = (size_t)(BK * 2);
    const size_t hstep = (size_t)HALF * K * 2;
    const size_t tstep = 2 * hstep;
    const unsigned ldsw = (unsigned)wid * 1024u;
    const int aoff = lds_byte(wr * 64 + fr, fq * 8), boff = lds_byte(wc * 32 + fr, fq * 8);
#define PG8_SA(b, h) (((b) * 2 + (h)) * HTB)
#define PG8_SB(b, h) ((4 + (b) * 2 + (h)) * HTB)
#define PG8_STAGE(bufoff, gbase, voff) do { _Pragma("unroll") for (int _i = 0; _i < 2; ++_i) \
        __builtin_amdgcn_global_load_lds((const unsigned*)((const char*)(gbase) + (voff)[_i]), (PG8_LAS unsigned*)(lds + (bufoff) + ldsw + _i * 8192), 16, 0, 0); } while (0)
#define PG8_LDA(dst, b, h) do { _Pragma("unroll") for (int m = 0; m < 4; ++m) _Pragma("unroll") for (int k = 0; k < 2; ++k) dst[m][k] = *(const PG8_LAS bf16x8*)(lds + PG8_SA(b, h) + aoff + m * 2048 + k * 1024); } while (0)
#define PG8_LDB(dst, b, h) do { _Pragma("unroll") for (int n = 0; n < 2; ++n) _Pragma("unroll") for (int k = 0; k < 2; ++k) dst[n][k] = *(const PG8_LAS bf16x8*)(lds + PG8_SB(b, h) + boff + n * 2048 + k * 1024); } while (0)
#define PG8_MMA(ai, bj, At, Bt) do { __builtin_amdgcn_s_setprio(1); _Pragma("unroll") for (int m = 0; m < 4; ++m) _Pragma("unroll") for (int n = 0; n < 2; ++n) _Pragma("unroll") for (int k = 0; k < 2; ++k) \
        acc[ai][bj][m][n] = __builtin_amdgcn_mfma_f32_16x16x32_bf16(Bt[n][k], At[m][k], acc[ai][bj][m][n], 0, 0, 0); __builtin_amdgcn_s_setprio(0); } while (0)
#define PG8_WAIT_V(n) asm volatile("s_waitcnt vmcnt(" #n ")" ::: "memory")
#define PG8_WAIT_L(n) asm volatile("s_waitcnt lgkmcnt(" #n ")" ::: "memory")
#define PG8_BAR __builtin_amdgcn_s_barrier()
#define PG8_SCHED __builtin_amdgcn_sched_barrier(0)
    Unit cur, nxt; int ui = 0;
    if (!S.next(0, cur)) return;
    f32x4 acc[2][2][4][2];
#pragma unroll
    for (int a = 0; a < 2; ++a)
#pragma unroll
        for (int b = 0; b < 2; ++b)
#pragma unroll
            for (int m = 0; m < 4; ++m)
#pragma unroll
                for (int n = 0; n < 2; ++n) acc[a][b][m][n] = (f32x4){0.f, 0.f, 0.f, 0.f};
    bf16x8 At[4][2], B0[2][2], B1[2][2];
    const char* cA = (const char*)g.A + (size_t)cur.pm * tstep; const char* cB = (const char*)g.Bt + (size_t)cur.pn * tstep;
    S.a_ready(cur);
    if constexpr (SP2) {
        PG8_STAGE(PG8_SB(0, 0), cB, voffB); PG8_STAGE(PG8_SB(0, 1), cB + hstep, voffB); PG8_STAGE(PG8_SA(0, 0), cA, voffA); PG8_STAGE(PG8_SA(0, 1), cA + hstep, voffA);
        if (wr == 1) PG8_BAR;
        PG8_WAIT_V(2); PG8_BAR;
        PG8_STAGE(PG8_SB(1, 0), cB + kstep, voffB); PG8_STAGE(PG8_SA(1, 0), cA + kstep, voffA); PG8_STAGE(PG8_SB(1, 1), cB + hstep + kstep, voffB);
        PG8_WAIT_V(6); PG8_BAR;
    } else {
        PG8_STAGE(PG8_SB(0, 0), cB, voffB); PG8_STAGE(PG8_SA(0, 0), cA, voffA); PG8_STAGE(PG8_SB(0, 1), cB + hstep, voffB); PG8_STAGE(PG8_SA(0, 1), cA + hstep, voffA);
        if (wr == 1) PG8_BAR;
        PG8_WAIT_V(4); PG8_BAR;
        PG8_STAGE(PG8_SB(1, 0), cB + kstep, voffB); PG8_STAGE(PG8_SA(1, 0), cA + kstep, voffA); PG8_STAGE(PG8_SB(1, 1), cB + hstep + kstep, voffB);
        PG8_WAIT_V(6); PG8_BAR;
    }
    for (;;) {
        const bool has_next = S.next(ui + 1, nxt);
        const char* nA = has_next ? (const char*)g.A + (size_t)nxt.pm * tstep : cA; const char* nB = has_next ? (const char*)g.Bt + (size_t)nxt.pn * tstep : cB;
        for (int t = 0; t < nt; t += 2) {
            const bool last = (t == nt - 2);
            const char* a1 = cA + (size_t)(t + 1) * kstep;
            const char* a2 = last ? nA : cA + (size_t)(t + 2) * kstep; const char* b2 = last ? nB : cB + (size_t)(t + 2) * kstep;
            const char* a3 = a2 + kstep; const char* b3 = b2 + kstep;
            if (last && has_next) S.a_ready(nxt);
            if constexpr (SP2) {
            PG8_LDB(B0, 0, 0); PG8_LDB(B1, 0, 1); PG8_SCHED; PG8_LDA(At, 0, 0); PG8_STAGE(PG8_SA(1, 1), a1 + hstep, voffA);
            PG8_WAIT_V(8); PG8_WAIT_L(0); PG8_BAR; PG8_MMA(0, 0, At, B0); PG8_MMA(0, 1, At, B1); PG8_BAR; PG8_SCHED;
            PG8_LDA(At, 0, 1); PG8_STAGE(PG8_SB(0, 0), b2, voffB); PG8_STAGE(PG8_SB(0, 1), b2 + hstep, voffB); PG8_STAGE(PG8_SA(0, 0), a2, voffA);
            PG8_WAIT_V(8); PG8_WAIT_L(0); PG8_BAR; PG8_MMA(1, 0, At, B0); PG8_MMA(1, 1, At, B1); PG8_BAR; PG8_SCHED;
            PG8_LDB(B0, 1, 0); PG8_LDB(B1, 1, 1); PG8_SCHED; PG8_LDA(At, 1, 0); PG8_STAGE(PG8_SA(0, 1), a2 + hstep, voffA);
            PG8_WAIT_V(8); PG8_WAIT_L(0); PG8_BAR; PG8_MMA(0, 0, At, B0); PG8_MMA(0, 1, At, B1); PG8_BAR; PG8_SCHED;
            PG8_LDA(At, 1, 1); PG8_STAGE(PG8_SB(1, 0), b3, voffB); PG8_STAGE(PG8_SB(1, 1), b3 + hstep, voffB); PG8_STAGE(PG8_SA(1, 0), a3, voffA);
            PG8_WAIT_V(8); PG8_WAIT_L(0); PG8_BAR; PG8_MMA(1, 0, At, B0); PG8_MMA(1, 1, At, B1); PG8_BAR; PG8_SCHED;
            } else {
            PG8_LDB(B0, 0, 0); PG8_SCHED; PG8_LDA(At, 0, 0); PG8_STAGE(PG8_SA(1, 1), a1 + hstep, voffA);
            PG8_WAIT_L(8); PG8_BAR; PG8_WAIT_L(0); PG8_MMA(0, 0, At, B0); PG8_BAR; PG8_SCHED;
            PG8_LDB(B1, 0, 1); PG8_STAGE(PG8_SB(0, 0), b2, voffB);
            PG8_BAR; PG8_WAIT_L(0); PG8_MMA(0, 1, At, B1); PG8_BAR;
            PG8_LDA(At, 0, 1); PG8_STAGE(PG8_SA(0, 0), a2, voffA);
            PG8_BAR; PG8_WAIT_L(0); PG8_MMA(1, 0, At, B0); PG8_BAR; PG8_SCHED;
            PG8_STAGE(PG8_SB(0, 1), b2 + hstep, voffB);
            PG8_WAIT_V(6); PG8_BAR; PG8_MMA(1, 1, At, B1); PG8_BAR;
            PG8_LDB(B0, 1, 0); PG8_SCHED; PG8_LDA(At, 1, 0); PG8_STAGE(PG8_SA(0, 1), a2 + hstep, voffA);
            PG8_WAIT_L(8); PG8_BAR; PG8_WAIT_L(0); PG8_MMA(0, 0, At, B0); PG8_BAR; PG8_SCHED;
            PG8_LDB(B1, 1, 1); PG8_STAGE(PG8_SB(1, 0), b3, voffB);
            PG8_BAR; PG8_WAIT_L(0); PG8_MMA(0, 1, At, B1); PG8_BAR;
            PG8_LDA(At, 1, 1); PG8_STAGE(PG8_SA(1, 0), a3, voffA);
            PG8_BAR; PG8_WAIT_L(0); PG8_MMA(1, 0, At, B0); PG8_BAR; PG8_SCHED;
            PG8_STAGE(PG8_SB(1, 1), b3 + hstep, voffB);
            PG8_WAIT_V(6); PG8_BAR; PG8_MMA(1, 1, At, B1); PG8_BAR;
            }
        }
        if constexpr (ALIGN_EPI) { if (wr == 0) PG8_BAR; }
        if constexpr (!Epi::AFTER_DRAIN) { E(acc, cur, wr, wc, fr, fq); S.done(cur); }
        if (!has_next) break;
#pragma unroll
        for (int a = 0; a < 2; ++a)
#pragma unroll
            for (int b = 0; b < 2; ++b)
#pragma unroll
                for (int m = 0; m < 4; ++m)
#pragma unroll
                    for (int n = 0; n < 2; ++n) acc[a][b][m][n] = (f32x4){0.f, 0.f, 0.f, 0.f};
        cur = nxt; cA = nA; cB = nB; ++ui;
        if constexpr (ALIGN_EPI) { if (wr == 1) PG8_BAR; }
    }
    PG8_WAIT_V(0);
    if constexpr (!ALIGN_EPI) { if (wr == 0) PG8_BAR; }
    PG8_BAR;
    if constexpr (Epi::AFTER_DRAIN) { E.fused(acc, cur, wr, wc, fr, fq, lds, wid, lane); S.done(cur); }
#undef PG8_SA
#undef PG8_SB
#undef PG8_STAGE
#undef PG8_LDA
#undef PG8_LDB
#undef PG8_MMA
#undef PG8_WAIT_V
#undef PG8_WAIT_L
#undef PG8_BAR
#undef PG8_SCHED
}
}

constexpr int BATCH = 4, SEQ = 8192, DM = 1024, MTOK = BATCH * SEQ, DFF = 2816, NPA = 1792, NPB = 1536, NIN = 3328, NMOD = 9 * 1024;
constexpr size_t MiB = 1u << 20;
constexpr size_t WS_MOD = 0;
constexpr size_t WS_QCTR = 512 * 1024;
constexpr size_t WS_BAR = 768 * 1024;
constexpr size_t WS_W = 1 * MiB;
constexpr size_t WS_W13_1 = WS_W, WS_W2_1 = WS_W13_1 + 11 * MiB, WS_W13_2 = WS_W2_1 + 11 * MiB / 2, WS_W2_2 = WS_W13_2 + 11 * MiB;
constexpr size_t WS_WIN = WS_W2_2 + 11 * MiB / 2, WS_WOUT = WS_WIN + 13 * MiB / 2, WS_WDU = WS_WOUT + 2 * MiB, WS_WAU = WS_WDU + 65536, WS_WGU = WS_WAU + 65536;
constexpr size_t WS_XN = 43 * MiB;
constexpr size_t WS_G = WS_XN, WS_SS = WS_XN + 32 * MiB;
constexpr size_t WS_PA = 107 * MiB;
constexpr size_t WS_PB = 219 * MiB;
constexpr size_t WS_HID = WS_PA;
constexpr size_t WS_MIX = WS_PA;
constexpr size_t WS_Y = WS_PA + 64 * MiB;
constexpr size_t WS_SC = 315 * MiB;
constexpr size_t WS_END = 507 * MiB;
static_assert(WS_WGU + 131072 <= WS_XN && WS_Y + 32 * MiB <= WS_PB && WS_HID + (size_t)MTOK * DFF * 2 <= WS_SC && WS_PB + 96 * MiB == WS_SC, "ws map");
constexpr int LDS_BYTES = 147456;

#define LAS __attribute__((address_space(3)))
typedef unsigned short bf16_t;
typedef float f32x4 __attribute__((ext_vector_type(4)));
typedef float f32x16 __attribute__((ext_vector_type(16)));
typedef unsigned u32x4 __attribute__((ext_vector_type(4)));
typedef unsigned u32x2 __attribute__((ext_vector_type(2)));
typedef short bf16x8 __attribute__((ext_vector_type(8)));
typedef _Float16 h16;
typedef _Float16 h16x4 __attribute__((ext_vector_type(4)));
typedef _Float16 h16x8 __attribute__((ext_vector_type(8)));

#define LDS_WAIT() asm volatile("s_waitcnt lgkmcnt(0)" ::: "memory")
#define BAR_LDS() do { asm volatile("s_waitcnt lgkmcnt(0)" ::: "memory"); __builtin_amdgcn_s_barrier(); asm volatile("" ::: "memory"); } while (0)
typedef float f32x2c __attribute__((ext_vector_type(2))); typedef __bf16 bf16x2c __attribute__((ext_vector_type(2)));
__device__ __forceinline__ unsigned pk2(float lo, float hi) { const f32x2c v = {lo, hi}; const bf16x2c b = __builtin_convertvector(v, bf16x2c); return __builtin_bit_cast(unsigned, b); }
__device__ __forceinline__ float bflo(unsigned w) { return __uint_as_float(w << 16); }
__device__ __forceinline__ float bfhi(unsigned w) { return __uint_as_float(w & 0xffff0000u); }
__device__ __forceinline__ float fast_sigmoid(float x) { return __builtin_amdgcn_rcpf(1.f + __expf(-x)); }
__device__ __forceinline__ float silu_f(float x) { return x * fast_sigmoid(x); }
__device__ __forceinline__ float wave_sum(float v) {
#pragma unroll
    for (int o = 1; o < 64; o <<= 1) v += __shfl_xor(v, o);
    return v;
}
template <int CTRL> __device__ __forceinline__ float dpp_f(float x) { return __builtin_bit_cast(float, __builtin_amdgcn_mov_dpp(__builtin_bit_cast(int, x), CTRL, 0xf, 0xf, true)); }
__device__ __forceinline__ float row16_sum(float x) {
    x += dpp_f<0xB1>(x); x += dpp_f<0x4E>(x); x += dpp_f<0x141>(x); x += dpp_f<0x128>(x); return x;
}

struct EpiSwiGLU {
    static constexpr bool PERM = true, AFTER_DRAIN = false;
    bf16_t* O; int ldc;
    __device__ __forceinline__ void operator()(const f32x4 (&acc)[2][2][4][2], const pg8::Unit& u, int wr, int wc, int fr, int fq) const {
        const int row0 = u.pm * 256 + wr * 64 + fr, col0 = u.pn * 128 + wc * 32 + 8 * fq;
#pragma unroll
        for (int ai = 0; ai < 2; ++ai)
#pragma unroll
            for (int m = 0; m < 4; ++m) {
                bf16_t* rowp = O + (size_t)(row0 + ai * 128 + m * 16) * ldc + col0;
                const f32x4 a0 = acc[ai][0][m][0], a1 = acc[ai][0][m][1], b0 = acc[ai][1][m][0], b1 = acc[ai][1][m][1];
                u32x4 w;
                w.x = pk2(silu_f(a0[0]) * b0[0], silu_f(a0[1]) * b0[1]); w.y = pk2(silu_f(a0[2]) * b0[2], silu_f(a0[3]) * b0[3]);
                w.z = pk2(silu_f(a1[0]) * b1[0], silu_f(a1[1]) * b1[1]); w.w = pk2(silu_f(a1[2]) * b1[2], silu_f(a1[3]) * b1[3]);
                *(u32x4*)rowp = w;
            }
    }
};
struct EpiResid {
    static constexpr bool PERM = true, AFTER_DRAIN = false;
    const float* base; float* out; const float* gate; float coef;
    __device__ __forceinline__ void operator()(const f32x4 (&acc)[2][2][4][2], const pg8::Unit& u, int wr, int wc, int fr, int fq) const {
        const int row0 = u.pm * 256 + wr * 64 + fr; const float* gp = gate + (size_t)(u.pm >> 5) * NMOD;
#pragma unroll
        for (int bj = 0; bj < 2; ++bj) {
            const int col = u.pn * 256 + bj * 128 + wc * 32 + 8 * fq;
            const f32x4 g0 = *(const f32x4*)(gp + col) * coef, g1 = *(const f32x4*)(gp + col + 4) * coef;
#pragma unroll
            for (int ai = 0; ai < 2; ++ai)
#pragma unroll
                for (int m = 0; m < 4; ++m) {
                    const size_t off = (size_t)(row0 + ai * 128 + m * 16) * DM + col;
                    const f32x4 x0 = *(const f32x4*)(base + off), x1 = *(const f32x4*)(base + off + 4);
                    *(f32x4*)(out + off) = x0 + g0 * acc[ai][bj][m][0]; *(f32x4*)(out + off + 4) = x1 + g1 * acc[ai][bj][m][1];
                    if (m & 1) asm volatile("" ::: "memory");
                }
        }
    }
};
struct EpiProj {
    static constexpr bool PERM = true, AFTER_DRAIN = false;
    bf16_t* PA; bf16_t* PB;
    __device__ __forceinline__ void operator()(const f32x4 (&acc)[2][2][4][2], const pg8::Unit& u, int wr, int wc, int fr, int fq) const {
        const int row0 = u.pm * 256 + wr * 64 + fr; int colt = u.pn * 256; bf16_t* bp = PA; int ld = NPA;
        if (colt >= NPA) { bp = PB; ld = NPB; colt -= NPA; }
        const int col0 = colt + wc * 32 + 8 * fq;
#pragma unroll
        for (int ai = 0; ai < 2; ++ai)
#pragma unroll
            for (int m = 0; m < 4; ++m) {
                bf16_t* rowp = bp + (size_t)(row0 + ai * 128 + m * 16) * ld + col0;
#pragma unroll
                for (int bj = 0; bj < 2; ++bj) {
                    const f32x4 v0 = acc[ai][bj][m][0], v1 = acc[ai][bj][m][1];
                    u32x4 w; w.x = pk2(v0[0], v0[1]); w.y = pk2(v0[2], v0[3]); w.z = pk2(v1[0], v1[1]); w.w = pk2(v1[2], v1[3]);
                    *(u32x4*)(rowp + bj * 128) = w;
                }
            }
    }
};

struct Params {
    const float *x, *c, *w_ada, *b_ada, *norm1_g, *f1w1, *f1w3, *f1w2, *norm2_g, *w_in, *mu, *w0, *wdu, *a0, *wau, *wgu, *k_k, *k_a, *r_k, *lnx_g, *lnx_b,
        *qn_g, *kn_g, *rel_bias, *w_out, *norm3_g, *f2w1, *f2w3, *f2w2;
    float* out; unsigned char* ws;
};

__device__ __forceinline__ int pi64(int cc) { return ((cc >> 2) & 3) * 16 + (cc >> 4) * 4 + (cc & 3); }
__device__ __forceinline__ void transpose_item(const float* W, int K, int N, bf16_t* WT, int k0, int n0, int drow0, LAS float* scr, int lane, bool perm = false) {
#pragma unroll
    for (int i = 0; i < 8; ++i) { const int kk = 8 * i + (lane >> 3), c4 = 4 * (lane & 7);
        const f32x4 v = *(const f32x4*)(W + (size_t)(k0 + kk) * N + n0 + c4);
        scr[kk * 33 + c4] = v.x; scr[kk * 33 + c4 + 1] = v.y; scr[kk * 33 + c4 + 2] = v.z; scr[kk * 33 + c4 + 3] = v.w; }
    LDS_WAIT();
    const int c = lane & 7;
#pragma unroll
    for (int j = 0; j < 4; ++j) { const int n = (lane >> 3) + 8 * j; const LAS float* s = scr + (8 * c) * 33 + n;
        u32x4 o; o.x = pk2(s[0 * 33], s[1 * 33]); o.y = pk2(s[2 * 33], s[3 * 33]); o.z = pk2(s[4 * 33], s[5 * 33]); o.w = pk2(s[6 * 33], s[7 * 33]);
        const int dr = perm ? (((drow0 + n) & ~63) + pi64((drow0 + n) & 63)) : drow0 + n;
        *(u32x4*)(WT + (size_t)dr * K + k0 + 8 * c) = o; }
    LDS_WAIT();
}
__device__ __forceinline__ void p0_convert(const Params& p, LAS unsigned char* lds, int gw, int ngw, int wave, int lane) {
    LAS float* scr = (LAS float*)(lds + wave * 8448);
    unsigned char* ws = p.ws;
    constexpr int I13 = 16 * 88, I2 = 44 * 32, IIN = 16 * 104, IOUT = 16 * 32, IDU = 16, IGU = 32;
    constexpr int NITEMS = 4 * I13 + 2 * I2 + IIN + IOUT + 2 * IDU + IGU;
    for (int it = gw; it < NITEMS; it += ngw) {
        int r = it;
#define W13_ITEM(src, dst, which) { const int kb = r / 88, nb = r % 88, n0 = nb * 32; transpose_item(src, 1024, DFF, (bf16_t*)(ws + dst), kb * 64, n0, (n0 >> 7) * 256 + which * 128 + (n0 & 127), scr, lane); continue; }
#define WPL_ITEM(src, dst, K_, N_) { const int nbn = N_ / 32, kb = r / nbn, nb = r % nbn; transpose_item(src, K_, N_, (bf16_t*)(ws + dst), kb * 64, nb * 32, nb * 32, scr, lane); continue; }
        if (r < I13) W13_ITEM(p.f1w1, WS_W13_1, 0) r -= I13;
        if (r < I13) W13_ITEM(p.f1w3, WS_W13_1, 1) r -= I13;
        if (r < I13) W13_ITEM(p.f2w1, WS_W13_2, 0) r -= I13;
        if (r < I13) W13_ITEM(p.f2w3, WS_W13_2, 1) r -= I13;
        if (r < I2) WPL_ITEM(p.f1w2, WS_W2_1, DFF, 1024) r -= I2;
        if (r < I2) WPL_ITEM(p.f2w2, WS_W2_2, DFF, 1024) r -= I2;
        if (r < IIN) { const int kb = r / 104, nb = r % 104; transpose_item(p.w_in, 1024, NIN, (bf16_t*)(ws + WS_WIN), kb * 64, nb * 32, nb * 32, scr, lane, nb * 32 < 1536); continue; } r -= IIN;
        if (r < IOUT) WPL_ITEM(p.w_out, WS_WOUT, 1024, 1024) r -= IOUT;
        if (r < IDU) WPL_ITEM(p.wdu, WS_WDU, 64, 512) r -= IDU;
        if (r < IDU) WPL_ITEM(p.wau, WS_WAU, 64, 512) r -= IDU;
        WPL_ITEM(p.wgu, WS_WGU, 128, 512)
#undef W13_ITEM
#undef WPL_ITEM
    }
}
__device__ __forceinline__ void p0_mod(const Params& p, LAS unsigned char* lds, int tid, int wave, int lane) {
    LAS float* sc = (LAS float*)(lds + 69632);
    LAS float* red = (LAS float*)(lds + 69632 + 16384);
    float* mod = (float*)(p.ws + WS_MOD);
    for (int i = tid; i < 4096; i += 512) sc[i] = silu_f(p.c[i]);
    __syncthreads();
    for (int item = blockIdx.x; item < NMOD / 32; item += gridDim.x) {
        const int col = lane & 31, ks = wave * 2 + (lane >> 5), k0 = ks * 64, n = item * 32 + col;
        float a0 = 0.f, a1 = 0.f, a2 = 0.f, a3 = 0.f;
#pragma unroll 8
        for (int kk = 0; kk < 64; ++kk) { const int k = k0 + kk; const float w = p.w_ada[(size_t)k * NMOD + n];
            a0 += sc[k] * w; a1 += sc[1024 + k] * w; a2 += sc[2048 + k] * w; a3 += sc[3072 + k] * w; }
        red[(ks * 4 + 0) * 32 + col] = a0; red[(ks * 4 + 1) * 32 + col] = a1; red[(ks * 4 + 2) * 32 + col] = a2; red[(ks * 4 + 3) * 32 + col] = a3;
        __syncthreads();
        if (tid < 128) { const int b = tid >> 5, cc = tid & 31; float s = p.b_ada[item * 32 + cc];
#pragma unroll
            for (int q = 0; q < 16; ++q) s += red[(q * 4 + b) * 32 + cc];
            mod[(size_t)b * NMOD + item * 32 + cc] = s; }
        __syncthreads();
    }
}

__device__ __forceinline__ void norm_phase(const float* src, const float* g, const float* mod, int ish, int isc, bf16_t* dst, LAS unsigned char* lds, int gw, int ngw, int wave, int lane) {
    LAS float* GSl = (LAS float*)lds; LAS float* SHl = GSl + 4096;
    for (int i = wave * 64 + lane; i < 4096; i += 512) { const int b = i >> 10, c = i & 1023; GSl[i] = g[c] * (1.f + mod[(size_t)b * NMOD + isc * 1024 + c]); SHl[i] = mod[(size_t)b * NMOD + ish * 1024 + c]; }
    BAR_LDS();
    for (int m = gw; m < MTOK; m += ngw) {
        const f32x4* xr = (const f32x4*)(src + (size_t)m * DM) + lane;
        f32x4 v[4]; float s = 0.f;
#pragma unroll
        for (int j = 0; j < 4; ++j) { v[j] = xr[64 * j]; s += (v[j].x * v[j].x + v[j].y * v[j].y) + (v[j].z * v[j].z + v[j].w * v[j].w); }
        s = wave_sum(s);
        const float rstd = rsqrtf(s * (1.f / DM) + 1e-6f);
        const int bo = (m >> 13) * 1024;
        u32x2* o8 = (u32x2*)(dst + (size_t)m * DM) + lane;
#pragma unroll
        for (int j = 0; j < 4; ++j) { const int c = bo + 4 * lane + 256 * j;
            const f32x4 gg = *(const LAS f32x4*)(GSl + c), h4 = *(const LAS f32x4*)(SHl + c);
            const f32x4 o = v[j] * rstd * gg + h4;
            u32x2 w; w.x = pk2(o.x, o.y); w.y = pk2(o.z, o.w); o8[64 * j] = w; }
    }
    BAR_LDS();
}

__device__ __forceinline__ f32x4 lerp4(const bf16_t* cur, const bf16_t* prv, bool first, const float* mu) {
    const u32x2 a = *(const u32x2*)cur; u32x2 q = *(const u32x2*)prv; if (first) { q.x = 0u; q.y = 0u; }
    const f32x4 m = *(const f32x4*)mu;
    const f32x4 x = {bflo(a.x), bfhi(a.x), bflo(a.y), bfhi(a.y)}, y = {bflo(q.x), bfhi(q.x), bflo(q.y), bfhi(q.y)};
    return x + (y - x) * m;
}
constexpr int PREP_PRM = 67584, PREP_WD = PREP_PRM + 16384, PREP_WA = PREP_WD + 9216, PREP_WG = PREP_WA + 9216;
__device__ __forceinline__ void prep_w_load(const Params& p, int h, int tid, u32x4 (&wr)[4]) {
    const bf16_t* Wdu = (const bf16_t*)(p.ws + WS_WDU); const bf16_t* Wau = (const bf16_t*)(p.ws + WS_WAU); const bf16_t* Wgu = (const bf16_t*)(p.ws + WS_WGU);
    wr[0] = *(const u32x4*)(Wdu + (size_t)(h * 64 + (tid >> 3)) * 64 + (tid & 7) * 8);
    wr[1] = *(const u32x4*)(Wau + (size_t)(h * 64 + (tid >> 3)) * 64 + (tid & 7) * 8);
    wr[2] = *(const u32x4*)(Wgu + (size_t)(h * 64 + (tid >> 4)) * 128 + (tid & 15) * 8);
    wr[3] = *(const u32x4*)(Wgu + (size_t)(h * 64 + 32 + (tid >> 4)) * 128 + (tid & 15) * 8);
}
__device__ __forceinline__ void prep_w_store(LAS unsigned char* lds, int tid, const u32x4 (&wr)[4]) {
    *(LAS u32x4*)((LAS bf16_t*)(lds + PREP_WD) + (tid >> 3) * 72 + (tid & 7) * 8) = wr[0];
    *(LAS u32x4*)((LAS bf16_t*)(lds + PREP_WA) + (tid >> 3) * 72 + (tid & 7) * 8) = wr[1];
    *(LAS u32x4*)((LAS bf16_t*)(lds + PREP_WG) + (tid >> 4) * 136 + (tid & 15) * 8) = wr[2];
    *(LAS u32x4*)((LAS bf16_t*)(lds + PREP_WG) + (32 + (tid >> 4)) * 136 + (tid & 15) * 8) = wr[3];
}
__device__ __forceinline__ void prep_rwkv_phase(const Params& p, LAS unsigned char* lds, int gw, int ngw, int wave, int lane) {
    const bf16_t* PA = (const bf16_t*)(p.ws + WS_PA);
    h16* SC = (h16*)(p.ws + WS_SC); float* SS = (float*)(p.ws + WS_SS); bf16_t* G = (bf16_t*)(p.ws + WS_G);
    LAS bf16_t* act = (LAS bf16_t*)(lds + wave * 8448);
    const LAS float* PRM = (const LAS float*)(lds + PREP_PRM);
    const LAS bf16_t* WD = (const LAS bf16_t*)(lds + PREP_WD); const LAS bf16_t* WA = (const LAS bf16_t*)(lds + PREP_WA); const LAS bf16_t* WG = (const LAS bf16_t*)(lds + PREP_WG);
    const int tid = wave * 64 + lane;
    for (int i = tid; i < 4096; i += 512) { const float* src = i < 1536 ? p.mu + i : i < 2048 ? p.w0 + (i - 1536) : i < 2560 ? p.a0 + (i - 2048) : i < 3072 ? p.k_k + (i - 2560) : i < 3584 ? p.k_a + (i - 3072) : p.r_k + (i - 3584);
        ((LAS float*)(lds + PREP_PRM))[i] = *src; }
    BAR_LDS();
    const int ntiles = MTOK / 16, niter = (ntiles + ngw - 1) / ngw;
    for (int kit = 0; kit < niter; ++kit) {
    const int item = gw + kit * ngw; const bool active = item < ntiles;
    const int m0 = (active ? item : 0) * 16, b = m0 >> 13;
    u32x4 wreg[4]; prep_w_load(p, 0, tid, wreg);
    if (active) {
        const int tk = lane >> 2, cq = lane & 3, m = m0 + tk; const bool first = (m & 8191) == 0;
        const bf16_t* pr = PA + (size_t)m * NPA + 1536 + cq * 64; const bf16_t* pp = first ? pr : pr - NPA;
#pragma unroll
        for (int g8 = 0; g8 < 8; ++g8) {
            const f32x4 x0 = lerp4(pr + g8 * 8, pp + g8 * 8, first, p.mu + 1536 + cq * 64 + g8 * 8);
            const f32x4 x1 = lerp4(pr + g8 * 8 + 4, pp + g8 * 8 + 4, first, p.mu + 1536 + cq * 64 + g8 * 8 + 4);
            float v[8] = {x0.x, x0.y, x0.z, x0.w, x1.x, x1.y, x1.z, x1.w};
#pragma unroll
            for (int e = 0; e < 8; ++e) { if (cq == 0) v[e] = 1.f - 2.f * __builtin_amdgcn_rcpf(__expf(2.f * v[e]) + 1.f); else if (cq >= 2) v[e] = fast_sigmoid(v[e]); }
            u32x4 w; w.x = pk2(v[0], v[1]); w.y = pk2(v[2], v[3]); w.z = pk2(v[4], v[5]); w.w = pk2(v[6], v[7]);
            *(LAS u32x4*)(act + tk * 264 + cq * 64 + g8 * 8) = w;
        }
    }
    prep_w_store(lds, tid, wreg);
    BAR_LDS();
    const int fr = lane & 15, fq = lane >> 4;
    const int m = m0 + fr, tin = m & 8191; const bool first = tin == 0;
    const bf16_t* prow = PA + (size_t)m * NPA; const bf16_t* pprev = first ? prow : prow - NPA;
#pragma unroll 1
    for (int h = 0; h < 8; ++h) {
        if (h < 7) prep_w_load(p, h + 1, tid, wreg);
        if (active) {
        {
            f32x4 accG[4];
#pragma unroll
            for (int i = 0; i < 4; ++i) { accG[i] = (f32x4){0.f, 0.f, 0.f, 0.f};
#pragma unroll
                for (int ks = 0; ks < 4; ++ks) {
                    const bf16x8 wg = *(const LAS bf16x8*)(WG + (i * 16 + fr) * 136 + ks * 32 + fq * 8), ag = *(const LAS bf16x8*)(act + fr * 264 + 128 + ks * 32 + fq * 8);
                    accG[i] = __builtin_amdgcn_mfma_f32_16x16x32_bf16(wg, ag, accG[i], 0, 0, 0); } }
#pragma unroll
            for (int hf = 0; hf < 2; ++hf)
                *(u32x4*)(G + (size_t)m * 512 + h * 64 + fq * 16 + hf * 8) = (u32x4){pk2(accG[2 * hf][0], accG[2 * hf][1]), pk2(accG[2 * hf][2], accG[2 * hf][3]), pk2(accG[2 * hf + 1][0], accG[2 * hf + 1][1]), pk2(accG[2 * hf + 1][2], accG[2 * hf + 1][3])};
        }
        f32x4 accD[4], accA[4];
#pragma unroll
        for (int i = 0; i < 4; ++i) {
            accD[i] = (f32x4){0.f, 0.f, 0.f, 0.f}; accA[i] = accD[i];
#pragma unroll
            for (int ks = 0; ks < 2; ++ks) {
                const bf16x8 wd = *(const LAS bf16x8*)(WD + (i * 16 + fr) * 72 + ks * 32 + fq * 8), ad = *(const LAS bf16x8*)(act + fr * 264 + ks * 32 + fq * 8);
                accD[i] = __builtin_amdgcn_mfma_f32_16x16x32_bf16(wd, ad, accD[i], 0, 0, 0);
                const bf16x8 wa = *(const LAS bf16x8*)(WA + (i * 16 + fr) * 72 + ks * 32 + fq * 8), aa = *(const LAS bf16x8*)(act + fr * 264 + 64 + ks * 32 + fq * 8);
                accA[i] = __builtin_amdgcn_mfma_f32_16x16x32_bf16(wa, aa, accA[i], 0, 0, 0);
            }
        }
        float nk = 0.f, sbr = 0.f, skr = 0.f, sbo = 0.f;
#pragma unroll
        for (int hf = 0; hf < 2; ++hf) {
            const int o_ = h * 64 + fq * 16 + hf * 8;
            const u32x4 kc = *(const u32x4*)(prow + 512 + o_); u32x4 kp = *(const u32x4*)(pprev + 512 + o_); if (first) kp = (u32x4){0u, 0u, 0u, 0u};
#pragma unroll
            for (int i2 = 0; i2 < 2; ++i2) { const int c = h * 64 + (2 * hf + i2) * 16 + 4 * fq; const f32x4 muk = *(const LAS f32x4*)(PRM + 512 + c), kk4 = *(const LAS f32x4*)(PRM + 2560 + c);
#pragma unroll
                for (int j = 0; j < 4; ++j) { const int e8 = i2 * 4 + j; const unsigned wc_ = kc[e8 >> 1], wp_ = kp[e8 >> 1];
                    const float kcur = (e8 & 1) ? bfhi(wc_) : bflo(wc_), kprv = (e8 & 1) ? bfhi(wp_) : bflo(wp_); const float kr_ = (kcur + (kprv - kcur) * muk[j]) * kk4[j]; nk += kr_ * kr_; } }
        }
        nk += __shfl_xor(nk, 16); nk += __shfl_xor(nk, 32);
        const float inv = 1.f / fmaxf(sqrtf(nk), 1e-12f);
        h16* scp = SC + ((size_t)(b * 8 + h) * SEQ + tin) * 384 + fq * 16;
#pragma unroll
        for (int hf = 0; hf < 2; ++hf) {
            h16x8 owr, odec, ok2, ov, okk, ob;
            const int o_ = h * 64 + fq * 16 + hf * 8;
            const u32x4 rc = *(const u32x4*)(prow + o_), kc = *(const u32x4*)(prow + 512 + o_), vc = *(const u32x4*)(prow + 1024 + o_);
            u32x4 rp = *(const u32x4*)(pprev + o_), kp = *(const u32x4*)(pprev + 512 + o_), vp = *(const u32x4*)(pprev + 1024 + o_);
            if (first) { rp = (u32x4){0u, 0u, 0u, 0u}; kp = rp; vp = rp; }
#pragma unroll
            for (int i2 = 0; i2 < 2; ++i2) {
                const int i = 2 * hf + i2, c = h * 64 + i * 16 + 4 * fq;
                const f32x4 mur = *(const LAS f32x4*)(PRM + c), muk = *(const LAS f32x4*)(PRM + 512 + c), muv = *(const LAS f32x4*)(PRM + 1024 + c);
                const f32x4 w04 = *(const LAS f32x4*)(PRM + 1536 + c), a04 = *(const LAS f32x4*)(PRM + 2048 + c), kk4 = *(const LAS f32x4*)(PRM + 2560 + c), ka4 = *(const LAS f32x4*)(PRM + 3072 + c), rk4 = *(const LAS f32x4*)(PRM + 3584 + c);
#pragma unroll
                for (int j = 0; j < 4; ++j) {
                    const int e8 = i2 * 4 + j, e = hf * 8 + e8; const unsigned wsel = (e8 >> 1); const bool hiw = e8 & 1;
#define PREP_GET(arr) ({ const unsigned w_ = arr[wsel]; hiw ? bfhi(w_) : bflo(w_); })
                    const float rcur = PREP_GET(rc), rprv = PREP_GET(rp), kcur = PREP_GET(kc), kprv = PREP_GET(kp), vcur = PREP_GET(vc), vprv = PREP_GET(vp);
#undef PREP_GET
                    const float r = rcur + (rprv - rcur) * mur[j], k = kcur + (kprv - kcur) * muk[j], v = vcur + (vprv - vcur) * muv[j];
                    const float dec = __expf(-0.60653066f * fast_sigmoid(w04[j] + accD[i][j]));
                    const float a = fast_sigmoid(a04[j] + accA[i][j]);
                    const float kraw = k * kk4[j], k2 = k * (1.f + (a - 1.f) * ka4[j]);
                    const float kkn = kraw * inv, bn = kkn * a; sbr += bn * r; skr += k2 * r; sbo += r * k2 * rk4[j];
                    okk[e8] = (h16)kkn; ob[e8] = (h16)bn;
                    owr[e8] = (h16)(dec * r); odec[e8] = (h16)dec; ok2[e8] = (h16)k2; ov[e8] = (h16)v;
                }
            }
            *(h16x8*)(scp + 0 * 64 + hf * 8) = okk; *(h16x8*)(scp + 3 * 64 + hf * 8) = ob; *(h16x8*)(scp + 1 * 64 + hf * 8) = owr; *(h16x8*)(scp + 2 * 64 + hf * 8) = odec; *(h16x8*)(scp + 4 * 64 + hf * 8) = ok2; *(h16x8*)(scp + 5 * 64 + hf * 8) = ov;
        }
        sbr += __shfl_xor(sbr, 16); sbr += __shfl_xor(sbr, 32); skr += __shfl_xor(skr, 16); skr += __shfl_xor(skr, 32); sbo += __shfl_xor(sbo, 16); sbo += __shfl_xor(sbo, 32);
        if (fq == 0) *(f32x4*)(SS + ((size_t)(b * 8 + h) * SEQ + tin) * 4) = (f32x4){sbr, skr, sbo, 0.f};
        }
        BAR_LDS();
        if (h < 7) { prep_w_store(lds, tid, wreg); BAR_LDS(); }
    }
    }
}
constexpr float QSCALE = 0.125f * 1.4426950408889634f;
__device__ __forceinline__ int frag_off(int f, int l) { return (f * 8 + (l >> 3)) * NPB + (l & 7) * 8; }
__device__ __forceinline__ void qk_norm_block(bf16_t* blk, int lane, const float* g, float mul) {
    const bf16_t* rowp = blk + (size_t)lane * NPB;
    u32x4 q[8]; float ss = 0.f;
#pragma unroll
    for (int i = 0; i < 8; ++i) { q[i] = *(const u32x4*)(rowp + i * 8);
        const float a0 = bflo(q[i].x), a1 = bfhi(q[i].x), a2 = bflo(q[i].y), a3 = bfhi(q[i].y), a4 = bflo(q[i].z), a5 = bfhi(q[i].z), a6 = bflo(q[i].w), a7 = bfhi(q[i].w);
        ss += (a0 * a0 + a1 * a1) + (a2 * a2 + a3 * a3) + (a4 * a4 + a5 * a5) + (a6 * a6 + a7 * a7); }
    const float sc = rsqrtf(ss * (1.f / 64.f) + 1e-6f) * mul;
    asm volatile("" ::: "memory");
#pragma unroll
    for (int i = 0; i < 8; ++i) { const f32x4 g0 = *(const f32x4*)(g + i * 8) * sc, g1 = *(const f32x4*)(g + i * 8 + 4) * sc; u32x4 w;
        w.x = pk2(bflo(q[i].x) * g0.x, bfhi(q[i].x) * g0.y); w.y = pk2(bflo(q[i].y) * g0.z, bfhi(q[i].y) * g0.w);
        w.z = pk2(bflo(q[i].z) * g1.x, bfhi(q[i].z) * g1.y); w.w = pk2(bflo(q[i].w) * g1.z, bfhi(q[i].w) * g1.w);
        *(u32x4*)(blk + frag_off((lane >> 5) * 4 + (i >> 1), (lane & 31) + 32 * (i & 1))) = w; }
}
__device__ __forceinline__ void prep_attn_item(const Params& p, LAS unsigned char* ldsw, int item, int lane) {
    bf16_t* PB = (bf16_t*)(p.ws + WS_PB);
    const int ch = item >> 3, h = item & 7;
    bf16_t* blk = PB + (size_t)(ch * 64) * NPB + h * 64;
    qk_norm_block(blk, lane, p.qn_g, QSCALE);
    qk_norm_block(blk + 512, lane, p.kn_g, 1.f);
    bf16_t* vblk = blk + 1024;
    LAS unsigned* tile = (LAS unsigned*)ldsw;
#pragma unroll
    for (int i = 0; i < 8; ++i) { const u32x4 v = *(const u32x4*)(vblk + (size_t)lane * NPB + i * 8);
        tile[lane * 33 + i * 4 + 0] = v.x; tile[lane * 33 + i * 4 + 1] = v.y; tile[lane * 33 + i * 4 + 2] = v.z; tile[lane * 33 + i * 4 + 3] = v.w; }
    LDS_WAIT();
    const LAS bf16_t* th = (const LAS bf16_t*)ldsw;
    unsigned w[32];
#pragma unroll
    for (int e = 0; e < 32; ++e) w[e] = (unsigned)th[(2 * e) * 66 + lane] | ((unsigned)th[(2 * e + 1) * 66 + lane] << 16);
#pragma unroll
    for (int s_ = 0; s_ < 4; ++s_)
#pragma unroll
        for (int hi = 0; hi < 2; ++hi)
            *(u32x4*)(vblk + frag_off((lane >> 5) * 4 + s_, (lane & 31) + 32 * hi)) = (u32x4){w[8 * s_ + 2 * hi], w[8 * s_ + 2 * hi + 1], w[8 * s_ + 4 + 2 * hi], w[8 * s_ + 4 + 2 * hi + 1]};
    LDS_WAIT();
}

constexpr int MS = 72;
__device__ __forceinline__ void mm64(const LAS bf16_t* Aop, const LAS bf16_t* Bop, f32x4 (&acc)[2], int wave, int fr, int fq) {
    const int a0 = 16 * (wave >> 1);
#pragma unroll
    for (int ks = 0; ks < 2; ++ks) {
        const bf16x8 bfr = *(const LAS bf16x8*)(Bop + (a0 + fr) * MS + ks * 32 + fq * 8);
#pragma unroll
        for (int nt = 0; nt < 2; ++nt) { const int b0 = 32 * (wave & 1) + 16 * nt;
            const bf16x8 afr = *(const LAS bf16x8*)(Aop + (b0 + fr) * MS + ks * 32 + fq * 8);
            acc[nt] = __builtin_amdgcn_mfma_f32_16x16x32_bf16(afr, bfr, acc[nt], 0, 0, 0); }
    }
}
__device__ __forceinline__ void st_bf4(LAS bf16_t* p, f32x4 v) { u32x2 w; w.x = pk2(v.x, v.y); w.y = pk2(v.z, v.w); *(LAS u32x2*)p = w; }
__device__ __forceinline__ h16* chunk_base(const Params& p, int item) { return (h16*)(p.ws + WS_SC) + ((size_t)(item >> 7) * SEQ + (size_t)(item & 127) * 64) * 384; }
__device__ __forceinline__ void chunk_load(const Params& p, int item, int tid, h16 (&raw)[48]) {
    const h16* base = chunk_base(p, item) + (size_t)(8 * (tid >> 6)) * 384 + (tid & 63);
#pragma unroll
    for (int i = 0; i < 8; ++i)
#pragma unroll
        for (int vq = 0; vq < 6; ++vq) raw[i * 6 + vq] = base[(size_t)i * 384 + vq * 64];
}
__device__ __forceinline__ void chunk_pre(const Params& p, LAS unsigned char* lds, int item, int next_item, int tid, int wave, int lane, h16 (&raw)[48]) {
    h16* base = chunk_base(p, item);
    LAS bf16_t* At = (LAS bf16_t*)lds; LAS bf16_t* Bt = At + 64 * MS; LAS bf16_t* Kt = Bt + 64 * MS; LAS bf16_t* Rt = Kt + 64 * MS;
    LAS bf16_t* BhT = Rt + 64 * MS; LAS bf16_t* KhT = BhT + 64 * MS; LAS bf16_t* VT = KhT + 64 * MS;
    LAS bf16_t* Mak = VT + 64 * MS; LAS bf16_t* Mrb = Mak + 64 * MS; LAS bf16_t* Mrk = Mrb + 64 * MS;
    LAS bf16_t* AbT = Bt; LAS bf16_t* P1T = Kt;
    LAS float* Mab = (LAS float*)(lds + 92160); LAS float* GT = (LAS float*)(lds + 141312);
    LAS bf16_t* AtT = (LAS bf16_t*)(lds + 108544); LAS bf16_t* RH2T = (LAS bf16_t*)(lds + 117760);
    LAS float* TD = (LAS float*)(lds + 126976); LAS float* Toff = (LAS float*)(lds + 131072); LAS float* Wf = (LAS float*)(lds + 137216);
    LAS bf16_t* Tb = At;
    const int fr = lane & 15, fq = lane >> 4;
    {
        const int g = tid >> 6, k = tid & 63;
        float wv[8], lp[8];
#pragma unroll
        for (int i = 0; i < 8; ++i) wv[i] = (float)raw[i * 6 + 2];
        lp[0] = wv[0];
#pragma unroll
        for (int i = 1; i < 8; ++i) lp[i] = lp[i - 1] * wv[i];
        GT[g * 64 + k] = lp[7];
        BAR_LDS();
        float bs = 1.f, WL = 1.f;
#pragma unroll
        for (int q = 0; q < 8; ++q) { const float gq = GT[q * 64 + k]; if (q < g) bs *= gq; WL *= gq; }
        float bhv[8], khv[8], vtv[8], atv[8];
#pragma unroll
        for (int i = 0; i < 8; ++i) {
            const int t = 8 * g + i;
            const float kk = (float)raw[i * 6 + 0], wr = (float)raw[i * 6 + 1], bb = (float)raw[i * 6 + 3], kx = (float)raw[i * 6 + 4], vv = (float)raw[i * 6 + 5];
            const float Wt = bs * lp[i], Wp = (i == 0) ? bs : bs * lp[i - 1], iW = 1.f / Wt;
            atv[i] = -kk * Wp; At[t * MS + k] = (bf16_t)(pk2(-kk * Wp, 0.f) & 0xffffu); Rt[t * MS + k] = (bf16_t)(pk2(wr * Wp, 0.f) & 0xffffu);
            Bt[t * MS + k] = (bf16_t)(pk2(bb * iW, 0.f) & 0xffffu); Kt[t * MS + k] = (bf16_t)(pk2(kx * iW, 0.f) & 0xffffu);
            bhv[i] = bb * iW * WL; khv[i] = kx * iW * WL; vtv[i] = vv;
        }
        *(LAS u32x4*)(BhT + k * MS + 8 * g) = (u32x4){pk2(bhv[0], bhv[1]), pk2(bhv[2], bhv[3]), pk2(bhv[4], bhv[5]), pk2(bhv[6], bhv[7])};
        *(LAS u32x4*)(KhT + k * MS + 8 * g) = (u32x4){pk2(khv[0], khv[1]), pk2(khv[2], khv[3]), pk2(khv[4], khv[5]), pk2(khv[6], khv[7])};
        *(LAS u32x4*)(VT + k * MS + 8 * g) = (u32x4){pk2(vtv[0], vtv[1]), pk2(vtv[2], vtv[3]), pk2(vtv[4], vtv[5]), pk2(vtv[6], vtv[7])};
        *(LAS u32x4*)(AtT + k * MS + 8 * g) = (u32x4){pk2(atv[0], atv[1]), pk2(atv[2], atv[3]), pk2(atv[4], atv[5]), pk2(atv[6], atv[7])};
    }
    if (next_item >= 0) chunk_load(p, next_item, tid, raw);
    BAR_LDS();
    const int a0 = 16 * (wave >> 1), ar = a0 + fr;
    {
        f32x4 acc[2];
#pragma unroll
        for (int which = 0; which < 4; ++which) {
            acc[0] = (f32x4){0.f, 0.f, 0.f, 0.f}; acc[1] = acc[0];
            mm64((which & 1) ? Kt : Bt, (which & 2) ? Rt : At, acc, wave, fr, fq);
#pragma unroll
            for (int nt = 0; nt < 2; ++nt) { const int s0 = 32 * (wave & 1) + 16 * nt + 4 * fq; f32x4 v = acc[nt];
#pragma unroll
                for (int jj = 0; jj < 4; ++jj) { const bool keep = (which & 2) ? (s0 + jj <= ar) : (s0 + jj < ar); if (!keep) v[jj] = 0.f; }
                if (which == 0) *(LAS f32x4*)(Mab + ar * 64 + s0) = v;
                else st_bf4(((which == 1) ? Mak : (which == 2) ? Mrb : Mrk) + ar * MS + s0, v); }
        }
    }
    BAR_LDS();
    {
        f32x4 acc[2]; acc[0] = (f32x4){0.f, 0.f, 0.f, 0.f}; acc[1] = acc[0];
        mm64(Mak, VT, acc, wave, fr, fq);
#pragma unroll
        for (int nt = 0; nt < 2; ++nt) st_bf4(RH2T + ar * MS + 32 * (wave & 1) + 16 * nt + 4 * fq, acc[nt]);
    }
    for (int e = tid; e < 6 * 256; e += 512) { const int ub = e >> 8, i = (e >> 4) & 15, j = e & 15;
        const int r = ub < 3 ? 0 : ub < 5 ? 1 : 2, c = ub < 3 ? ub + 1 : ub < 5 ? ub - 1 : 3; Tb[(16 * r + i) * MS + 16 * c + j] = 0; }
    if (tid < 64) {
        const int r = tid >> 4, j = tid & 15; float x[16];
#pragma unroll
        for (int i = 0; i < 16; ++i) x[i] = 0.f;
#pragma unroll
        for (int i = 0; i < 16; ++i) {
            const LAS float* mrow = Mab + (16 * r + i) * 64 + 16 * r;
            float v = (i == j) ? 1.f : 0.f;
#pragma unroll
            for (int q = 0; q < (i + 3) / 4; ++q) { const f32x4 m4 = *(const LAS f32x4*)(mrow + 4 * q);
                v += (m4.x * x[4 * q] + m4.y * x[4 * q + 1]) + (m4.z * x[4 * q + 2] + m4.w * x[4 * q + 3]); }
            x[i] = v; TD[r * 256 + i * 16 + j] = v; Tb[(16 * r + i) * MS + 16 * r + j] = (bf16_t)(pk2(v, 0.f) & 0xffffu);
        }
    }
    BAR_LDS();
#define M16(r_, q_, blkp) ({ const LAS float* mr_ = Mab + (16 * (r_) + i) * 64 + 16 * (q_); const LAS float* bp_ = (blkp) + j; float a_ = 0.f; \
        _Pragma("unroll") for (int u4 = 0; u4 < 4; ++u4) { const f32x4 m4 = *(const LAS f32x4*)(mr_ + 4 * u4); \
            a_ += (m4.x * bp_[(4 * u4) * 16] + m4.y * bp_[(4 * u4 + 1) * 16]) + (m4.z * bp_[(4 * u4 + 2) * 16] + m4.w * bp_[(4 * u4 + 3) * 16]); } a_; })
#define TDW(r_, wp) ({ const LAS float* tr_ = TD + (r_) * 256 + i * 16; const LAS float* bp_ = (wp) + j; float a_ = 0.f; \
        _Pragma("unroll") for (int u4 = 0; u4 < 4; ++u4) { const f32x4 t4 = *(const LAS f32x4*)(tr_ + 4 * u4); \
            a_ += (t4.x * bp_[(4 * u4) * 16] + t4.y * bp_[(4 * u4 + 1) * 16]) + (t4.z * bp_[(4 * u4 + 2) * 16] + t4.w * bp_[(4 * u4 + 3) * 16]); } a_; })
    for (int e = tid; e < 3 * 256; e += 512) { const int bk = e >> 8, i = (e >> 4) & 15, j = e & 15; Wf[bk * 256 + i * 16 + j] = M16(bk + 1, bk, TD + bk * 256); }
    BAR_LDS();
    for (int e = tid; e < 3 * 256; e += 512) { const int bk = e >> 8, i = (e >> 4) & 15, j = e & 15; const float t = TDW(bk + 1, Wf + bk * 256);
        Toff[bk * 256 + i * 16 + j] = t; Tb[(16 * (bk + 1) + i) * MS + 16 * bk + j] = (bf16_t)(pk2(t, 0.f) & 0xffffu); }
    BAR_LDS();
    { const int bk = tid >> 8, i = (tid >> 4) & 15, j = tid & 15; Wf[bk * 256 + i * 16 + j] = M16(bk + 2, bk, TD + bk * 256) + M16(bk + 2, bk + 1, Toff + bk * 256); }
    BAR_LDS();
    { const int bk = tid >> 8, i = (tid >> 4) & 15, j = tid & 15; const float t = TDW(bk + 2, Wf + bk * 256);
      Toff[(3 + bk) * 256 + i * 16 + j] = t; Tb[(16 * (bk + 2) + i) * MS + 16 * bk + j] = (bf16_t)(pk2(t, 0.f) & 0xffffu); }
    BAR_LDS();
    if (tid < 256) { const int i = tid >> 4, j = tid & 15; Wf[i * 16 + j] = M16(3, 0, TD) + M16(3, 1, Toff) + M16(3, 2, Toff + 3 * 256); }
    BAR_LDS();
    if (tid < 256) { const int i = tid >> 4, j = tid & 15; const float t = TDW(3, Wf); Tb[(48 + i) * MS + j] = (bf16_t)(pk2(t, 0.f) & 0xffffu); }
    BAR_LDS();
#undef M16
#undef TDW
    {
        f32x4 acc[2];
        acc[0] = (f32x4){0.f, 0.f, 0.f, 0.f}; acc[1] = acc[0]; mm64(Tb, AtT, acc, wave, fr, fq);
#pragma unroll
        for (int nt = 0; nt < 2; ++nt) st_bf4(AbT + ar * MS + 32 * (wave & 1) + 16 * nt + 4 * fq, acc[nt]);
        acc[0] = (f32x4){0.f, 0.f, 0.f, 0.f}; acc[1] = acc[0]; mm64(Tb, RH2T, acc, wave, fr, fq);
#pragma unroll
        for (int nt = 0; nt < 2; ++nt) st_bf4(P1T + ar * MS + 32 * (wave & 1) + 16 * nt + 4 * fq, acc[nt]);
    }
    BAR_LDS();
    {
        f32x4 acc[2];
        acc[0] = (f32x4){0.f, 0.f, 0.f, 0.f}; acc[1] = acc[0];
        mm64(AbT, Mrb, acc, wave, fr, fq);
#pragma unroll
        for (int nt = 0; nt < 2; ++nt) { const int b0 = 32 * (wave & 1) + 16 * nt + 4 * fq; const u32x2 rw = *(const LAS u32x2*)(Rt + ar * MS + b0);
            const f32x4 v = acc[nt] + (f32x4){bflo(rw.x), bfhi(rw.x), bflo(rw.y), bfhi(rw.y)};
            u32x2 w; w.x = pk2(v.x, v.y); w.y = pk2(v.z, v.w); *(u32x2*)(base + (size_t)(ar * 6 + 2) * 64 + b0) = w; }
        acc[0] = (f32x4){0.f, 0.f, 0.f, 0.f}; acc[1] = acc[0];
        mm64(P1T, Mrb, acc, wave, fr, fq); mm64(VT, Mrk, acc, wave, fr, fq);
#pragma unroll
        for (int nt = 0; nt < 2; ++nt) { const int b0 = 32 * (wave & 1) + 16 * nt + 4 * fq; *(f32x4*)((float*)(base + (size_t)(ar * 6 + 3) * 64) + b0) = acc[nt]; }
        acc[0] = (f32x4){0.f, 0.f, 0.f, 0.f}; acc[1] = acc[0];
        mm64(AbT, BhT, acc, wave, fr, fq);
        { float WL = 1.f;
#pragma unroll
          for (int q = 0; q < 8; ++q) WL *= GT[q * 64 + ar];
#pragma unroll
          for (int nt = 0; nt < 2; ++nt) { const int b0 = 32 * (wave & 1) + 16 * nt + 4 * fq; f32x4 v = acc[nt];
#pragma unroll
              for (int jj = 0; jj < 4; ++jj) if (b0 + jj == ar) v[jj] += WL;
              u32x2 w; w.x = pk2(v.x, v.y); w.y = pk2(v.z, v.w); *(u32x2*)(base + (size_t)(ar * 6 + 0) * 64 + b0) = w; } }
        acc[0] = (f32x4){0.f, 0.f, 0.f, 0.f}; acc[1] = acc[0];
        mm64(BhT, P1T, acc, wave, fr, fq); mm64(KhT, VT, acc, wave, fr, fq);
#pragma unroll
        for (int nt = 0; nt < 2; ++nt) { const int b0 = 32 * (wave & 1) + 16 * nt + 4 * fq; const f32x4 v = acc[nt];
            u32x2 w; w.x = pk2(v.x, v.y); w.y = pk2(v.z, v.w); *(u32x2*)(base + (size_t)(ar * 6 + 1) * 64 + b0) = w; }
    }
    BAR_LDS();
}
constexpr int CHAIN_LDS = 16640;
__device__ __forceinline__ void chain_head(const Params& p, LAS unsigned char* lds, int bh, int wave, int lane) {
    const int fr = lane & 15, fq = lane >> 4, a0 = 16 * (wave >> 1), ar = a0 + fr, bw = 32 * (wave & 1);
    LAS bf16_t* Sb = (LAS bf16_t*)(lds + CHAIN_LDS);
    LAS bf16_t* Pb = Sb + 2 * 64 * MS;
    LAS bf16_t* Zb = Pb + 2 * 64 * MS;
    h16* hb = (h16*)(p.ws + WS_SC) + (size_t)bh * SEQ * 384;
    for (int i = wave * 64 + lane; i < 2 * 64 * MS / 2; i += 512) ((LAS unsigned*)Sb)[i] = 0u;
    const int prow = 8 * wave + (lane >> 3), ppc = (lane & 7) * 8;
    u32x4 phA, phB, phC, phD, phE, phF, phG, phH, zzA, zzB, zzC, zzD, zzE, zzF, zzG, zzH;
#define CH_LOAD(X, cc_) do { const h16* base = hb + (size_t)(cc_) * 64 * 384; \
        ph##X = *(const u32x4*)(base + (size_t)(prow * 6 + 0) * 64 + ppc); zz##X = *(const u32x4*)(base + (size_t)(prow * 6 + 1) * 64 + ppc); } while (0)
#define CH_STEP(X, XN, cc_) do { const int c_ = (cc_); const LAS bf16_t* Sc = Sb + (c_ & 1) * (64 * MS); LAS bf16_t* Sn = Sb + ((c_ & 1) ^ 1) * (64 * MS); \
        const LAS bf16_t* Pc = Pb + (c_ & 1) * (64 * MS); LAS bf16_t* Pn = Pb + ((c_ & 1) ^ 1) * (64 * MS); \
        const LAS bf16_t* Zc = Zb + (c_ & 1) * (64 * MS); LAS bf16_t* Zn = Zb + ((c_ & 1) ^ 1) * (64 * MS); \
        h16* base = hb + (size_t)c_ * 64 * 384; f32x4 accs[2]; \
        *(u32x4*)(base + (size_t)(prow * 6 + 1) * 64 + ppc) = *(const LAS u32x4*)(Sc + prow * MS + ppc); \
        _Pragma("unroll") for (int nt = 0; nt < 2; ++nt) { const u32x2 z_ = *(const LAS u32x2*)(Zc + ar * MS + bw + 16 * nt + 4 * fq); accs[nt] = (f32x4){bflo(z_.x), bfhi(z_.x), bflo(z_.y), bfhi(z_.y)}; } \
        if (c_ + 1 < SEQ / 64) { *(LAS u32x4*)(Pn + prow * MS + ppc) = ph##XN; *(LAS u32x4*)(Zn + prow * MS + ppc) = zz##XN; } \
        if (c_ + 8 < SEQ / 64) CH_LOAD(X, c_ + 8); \
        _Pragma("unroll") for (int ks = 0; ks < 2; ++ks) { const bf16x8 sv = *(const LAS bf16x8*)(Sc + ar * MS + ks * 32 + fq * 8); \
            _Pragma("unroll") for (int nt = 0; nt < 2; ++nt) { const bf16x8 pf_ = *(const LAS bf16x8*)(Pc + (bw + 16 * nt + fr) * MS + ks * 32 + fq * 8); \
                accs[nt] = __builtin_amdgcn_mfma_f32_16x16x32_bf16(pf_, sv, accs[nt], 0, 0, 0); } } \
        _Pragma("unroll") for (int nt = 0; nt < 2; ++nt) st_bf4(Sn + ar * MS + bw + 16 * nt + 4 * fq, accs[nt]); \
        BAR_LDS(); } while (0)
    CH_LOAD(A, 0); CH_LOAD(B, 1); CH_LOAD(C, 2); CH_LOAD(D, 3); CH_LOAD(E, 4); CH_LOAD(F, 5); CH_LOAD(G, 6); CH_LOAD(H, 7);
    *(LAS u32x4*)(Pb + prow * MS + ppc) = phA; *(LAS u32x4*)(Zb + prow * MS + ppc) = zzA;
    BAR_LDS();
#pragma unroll
    for (int c = 0; c < SEQ / 64; c += 8) { CH_STEP(A, B, c); CH_STEP(B, C, c + 1); CH_STEP(C, D, c + 2); CH_STEP(D, E, c + 3); CH_STEP(E, F, c + 4); CH_STEP(F, G, c + 5); CH_STEP(G, H, c + 6); CH_STEP(H, A, c + 7); }
#undef CH_LOAD
#undef CH_STEP
}
__device__ __forceinline__ void rwkv_out_ch(const Params& p, LAS unsigned char* ldsw, int ch, int lane) {
    const int bh = ch >> 7, c = ch & 127, b = bh >> 3, h = bh & 7, fr = lane & 15, fq = lane >> 4;
    const h16* base = (const h16*)(p.ws + WS_SC) + ((size_t)bh * SEQ + (size_t)c * 64) * 384;
    const bf16_t* G = (const bf16_t*)(p.ws + WS_G); const float* SS = (const float*)(p.ws + WS_SS); bf16_t* MIX = (bf16_t*)(p.ws + WS_MIX);
    LAS bf16_t* stg = (LAS bf16_t*)ldsw;
    bf16x8 sf[4][2]; f32x4 lg[4], lb[4];
#pragma unroll
    for (int nt = 0; nt < 4; ++nt) {
#pragma unroll
        for (int ks = 0; ks < 2; ++ks) sf[nt][ks] = *(const bf16x8*)(base + (size_t)((16 * nt + fr) * 6 + 1) * 64 + ks * 32 + fq * 8);
        const int cc = h * 64 + 16 * fq + 4 * nt; lg[nt] = *(const f32x4*)(p.lnx_g + cc); lb[nt] = *(const f32x4*)(p.lnx_b + cc);
    }
#pragma unroll 1
    for (int ts = 0; ts < 4; ++ts) {
        const int t = 16 * ts + fr, tin = c * 64 + t; const size_t m = (size_t)b * SEQ + tin;
        bf16x8 rbf[2]; f32x4 acc[4];
#pragma unroll
        for (int ks = 0; ks < 2; ++ks) rbf[ks] = *(const bf16x8*)(base + (size_t)(t * 6 + 2) * 64 + ks * 32 + fq * 8);
#pragma unroll
        for (int nt = 0; nt < 4; ++nt) acc[nt] = *(const f32x4*)((const float*)(base + (size_t)(t * 6 + 3) * 64) + 16 * nt + 4 * fq);
        u32x2 gw2[4]; h16x4 v4[4];
#pragma unroll
        for (int nt = 0; nt < 4; ++nt) { const int v0 = 16 * nt + 4 * fq; gw2[nt] = *(const u32x2*)(G + m * 512 + h * 64 + v0); v4[nt] = *(const h16x4*)(base + (size_t)(t * 6 + 5) * 64 + v0); }
        const float bon = SS[((size_t)bh * SEQ + tin) * 4 + 2];
#pragma unroll
        for (int nt = 0; nt < 4; ++nt)
#pragma unroll
            for (int ks = 0; ks < 2; ++ks) acc[nt] = __builtin_amdgcn_mfma_f32_16x16x32_bf16(sf[nt][ks], rbf[ks], acc[nt], 0, 0, 0);
        float s_ = 0.f;
#pragma unroll
        for (int nt = 0; nt < 4; ++nt) s_ += (acc[nt].x + acc[nt].y) + (acc[nt].z + acc[nt].w);
        s_ += __shfl_xor(s_, 16); s_ += __shfl_xor(s_, 32);
        const float mean = s_ * (1.f / 64.f); float q = 0.f;
#pragma unroll
        for (int nt = 0; nt < 4; ++nt) { acc[nt] = acc[nt] - mean; q += (acc[nt].x * acc[nt].x + acc[nt].y * acc[nt].y) + (acc[nt].z * acc[nt].z + acc[nt].w * acc[nt].w); }
        q += __shfl_xor(q, 16); q += __shfl_xor(q, 32);
        const float rstd = rsqrtf(q * (1.f / 64.f) + 64e-5f);
#pragma unroll
        for (int nt = 0; nt < 4; ++nt) {
            const f32x4 g = {bflo(gw2[nt].x), bfhi(gw2[nt].x), bflo(gw2[nt].y), bfhi(gw2[nt].y)}, vv = {(float)v4[nt][0], (float)v4[nt][1], (float)v4[nt][2], (float)v4[nt][3]};
            st_bf4(stg + fr * MS + 16 * fq + 4 * nt, (acc[nt] * rstd * lg[nt] + lb[nt] + vv * bon) * g);
        }
        LDS_WAIT();
        {
            const int row = lane >> 2, pc = (lane & 3) * 16;
            const u32x4 w0 = *(const LAS u32x4*)(stg + row * MS + pc), w1 = *(const LAS u32x4*)(stg + row * MS + pc + 8);
            bf16_t* dst = MIX + ((size_t)b * SEQ + c * 64 + 16 * ts + row) * DM + h * 64 + pc;
            *(u32x4*)dst = w0; *(u32x4*)(dst + 8) = w1;
        }
        LDS_WAIT();
    }
}
__device__ __forceinline__ void rwkv_out_item(const Params& p, int item, int lane) {
    const int ts = item & 3, ch = item >> 2, bh = ch >> 7, c = ch & 127, b = bh >> 3, h = bh & 7, fr = lane & 15, fq = lane >> 4;
    const h16* base = (const h16*)(p.ws + WS_SC) + ((size_t)bh * SEQ + (size_t)c * 64) * 384;
    const int t = 16 * ts + fr, tin = c * 64 + t; const size_t m = (size_t)b * SEQ + tin;
    const bf16_t* G = (const bf16_t*)(p.ws + WS_G); const float* SS = (const float*)(p.ws + WS_SS); bf16_t* MIX = (bf16_t*)(p.ws + WS_MIX);
    bf16x8 rbf[2]; f32x4 acc[4];
#pragma unroll
    for (int ks = 0; ks < 2; ++ks) rbf[ks] = *(const bf16x8*)(base + (size_t)(t * 6 + 2) * 64 + ks * 32 + fq * 8);
#pragma unroll
    for (int nt = 0; nt < 4; ++nt) acc[nt] = *(const f32x4*)((const float*)(base + (size_t)(t * 6 + 3) * 64) + 16 * nt + 4 * fq);
#pragma unroll
    for (int nt = 0; nt < 4; ++nt)
#pragma unroll
        for (int ks = 0; ks < 2; ++ks) { const bf16x8 sf = *(const bf16x8*)(base + (size_t)((16 * nt + fr) * 6 + 1) * 64 + ks * 32 + fq * 8);
            acc[nt] = __builtin_amdgcn_mfma_f32_16x16x32_bf16(sf, rbf[ks], acc[nt], 0, 0, 0); }
    float s = 0.f;
#pragma unroll
    for (int nt = 0; nt < 4; ++nt) s += (acc[nt].x + acc[nt].y) + (acc[nt].z + acc[nt].w);
    s += __shfl_xor(s, 16); s += __shfl_xor(s, 32);
    const float mean = s * (1.f / 64.f); float q = 0.f;
#pragma unroll
    for (int nt = 0; nt < 4; ++nt) { acc[nt] = acc[nt] - mean; q += (acc[nt].x * acc[nt].x + acc[nt].y * acc[nt].y) + (acc[nt].z * acc[nt].z + acc[nt].w * acc[nt].w); }
    q += __shfl_xor(q, 16); q += __shfl_xor(q, 32);
    const float rstd = rsqrtf(q * (1.f / 64.f) + 64e-5f);
    const float bon = SS[((size_t)bh * SEQ + tin) * 4 + 2];
#pragma unroll
    for (int nt = 0; nt < 4; ++nt) { const int v0 = 16 * nt + 4 * fq  , cc = h * 64 + 16 * fq + 4 * nt  ;
        const f32x4 lg = *(const f32x4*)(p.lnx_g + cc), lb = *(const f32x4*)(p.lnx_b + cc);
        const u32x2 gw2 = *(const u32x2*)(G + m * 512 + h * 64 + v0); const h16x4 v4 = *(const h16x4*)(base + (size_t)(t * 6 + 5) * 64 + v0);
        const f32x4 g = {bflo(gw2.x), bfhi(gw2.x), bflo(gw2.y), bfhi(gw2.y)}, vv = {(float)v4[0], (float)v4[1], (float)v4[2], (float)v4[3]};
        const f32x4 o = (acc[nt] * rstd * lg + lb + vv * bon) * g;
        u32x2 w; w.x = pk2(o.x, o.y); w.y = pk2(o.z, o.w); *(u32x2*)(MIX + m * DM + cc) = w; }
}

__device__ __forceinline__ int crow(int r, int hi) { return (r & 3) + 8 * (r >> 2) + 4 * hi; }
__device__ __forceinline__ void attn_unit(const Params& p, const LAS float* bl, LAS bf16_t* stg, int unit, int lane) {
    const bf16_t* PB = (const bf16_t*)(p.ws + WS_PB); bf16_t* MIX = (bf16_t*)(p.ws + WS_MIX);
    const int half = unit & 1, cq = 127 - ((unit >> 1) & 127)  , bh = unit >> 8, b = bh >> 3, h = bh & 7;
    const int r32 = lane & 31, hi = lane >> 5;
    const unsigned loff = (unsigned)(((lane >> 3) * NPB + (lane & 7) * 8) * 2);
#define FRAGP(blk, f) ((const u32x4*)((const char*)(blk) + (size_t)(f) * (8 * NPB * 2) + loff))
    const size_t tok0 = (size_t)b * SEQ;
    const bf16_t* qblk = PB + (tok0 + cq * 64) * NPB + h * 64;
    bf16x8 qf[4];
#pragma unroll
    for (int d0 = 0; d0 < 4; ++d0) qf[d0] = __builtin_bit_cast(bf16x8, *FRAGP(qblk, half * 4 + d0));
    f32x16 o0 = {}, o1 = {}; float lsum = 0.f;
    const LAS float* blh = bl + h * 513;
    const int qi = half * 32 + r32;
    u32x4 kc[8], vc[8];
    const int dl0 = (cq < 8 ? cq : 8);
    { const bf16_t* kblk = PB + (tok0 + (size_t)(cq - dl0) * 64) * NPB + 512 + h * 64;
#pragma unroll
      for (int f = 0; f < 8; ++f) kc[f] = *FRAGP(kblk, f); }
    for (int dlt = dl0; dlt >= 0; --dlt) {
        const size_t krow0 = tok0 + (size_t)(cq - dlt) * 64;
        { const bf16_t* vblk = PB + krow0 * NPB + 1024 + h * 64;
#pragma unroll
          for (int f = 0; f < 8; ++f) vc[f] = *FRAGP(vblk, f); }
        __builtin_amdgcn_sched_barrier(0);
        f32x16 s0, s1;
        if (dlt >= 5) {
            const float bc = blh[512];
#pragma unroll
            for (int r = 0; r < 16; ++r) { s0[r] = bc; s1[r] = bc; }
        } else if (dlt == 4) {
            const int base = dlt * 64 + qi + 256;
#pragma unroll
            for (int r = 0; r < 16; ++r) { const int kv = crow(r, hi); int i0 = base - kv, i1 = base - kv - 32; i0 = i0 > 512 ? 512 : i0; i1 = i1 > 512 ? 512 : i1; s0[r] = blh[i0]; s1[r] = blh[i1]; }
        } else {
            const LAS float* bp = blh + (dlt * 64 + qi + 256 - 4 * hi - 59);
#pragma unroll
            for (int r = 0; r < 16; ++r) { const int k0 = (r & 3) + 8 * (r >> 2); s0[r] = bp[59 - k0]; s1[r] = bp[27 - k0]; }
        }
#pragma unroll
        for (int d0 = 0; d0 < 4; ++d0) {
            s0 = __builtin_amdgcn_mfma_f32_32x32x16_bf16(__builtin_bit_cast(bf16x8, kc[d0]), qf[d0], s0, 0, 0, 0);
            s1 = __builtin_amdgcn_mfma_f32_32x32x16_bf16(__builtin_bit_cast(bf16x8, kc[4 + d0]), qf[d0], s1, 0, 0, 0);
        }
        if (dlt > 0) { const bf16_t* kblk = PB + (krow0 + 64) * NPB + 512 + h * 64;
#pragma unroll
          for (int f = 0; f < 8; ++f) kc[f] = *FRAGP(kblk, f); }
        __builtin_amdgcn_sched_barrier(0);
#pragma unroll
        for (int r = 0; r < 16; ++r) { s0[r] = __builtin_amdgcn_exp2f(s0[r]); s1[r] = __builtin_amdgcn_exp2f(s1[r]); }
        float ls = 0.f;
#pragma unroll
        for (int r = 0; r < 16; ++r) ls += s0[r] + s1[r];
        lsum += ls;
        u32x4 pf[4];
        pf[0] = (u32x4){pk2(s0[0], s0[1]), pk2(s0[2], s0[3]), pk2(s0[4], s0[5]), pk2(s0[6], s0[7])};
        pf[1] = (u32x4){pk2(s0[8], s0[9]), pk2(s0[10], s0[11]), pk2(s0[12], s0[13]), pk2(s0[14], s0[15])};
        pf[2] = (u32x4){pk2(s1[0], s1[1]), pk2(s1[2], s1[3]), pk2(s1[4], s1[5]), pk2(s1[6], s1[7])};
        pf[3] = (u32x4){pk2(s1[8], s1[9]), pk2(s1[10], s1[11]), pk2(s1[12], s1[13]), pk2(s1[14], s1[15])};
#pragma unroll
        for (int s = 0; s < 4; ++s) {
            o0 = __builtin_amdgcn_mfma_f32_32x32x16_bf16(__builtin_bit_cast(bf16x8, vc[s]), __builtin_bit_cast(bf16x8, pf[s]), o0, 0, 0, 0);
            o1 = __builtin_amdgcn_mfma_f32_32x32x16_bf16(__builtin_bit_cast(bf16x8, vc[4 + s]), __builtin_bit_cast(bf16x8, pf[s]), o1, 0, 0, 0);
        }
    }
    lsum += __shfl_xor(lsum, 32);
    const float il = 1.f / lsum;
#pragma unroll
    for (int g = 0; g < 4; ++g) {
        st_bf4(stg + r32 * MS + 8 * g + 4 * hi, (f32x4){o0[4 * g] * il, o0[4 * g + 1] * il, o0[4 * g + 2] * il, o0[4 * g + 3] * il});
        st_bf4(stg + r32 * MS + 32 + 8 * g + 4 * hi, (f32x4){o1[4 * g] * il, o1[4 * g + 1] * il, o1[4 * g + 2] * il, o1[4 * g + 3] * il});
    }
    LDS_WAIT();
#pragma unroll
    for (int i = 0; i < 4; ++i) { const int row = 8 * i + (lane >> 3), pc = (lane & 7) * 8;
        *(u32x4*)(MIX + (tok0 + cq * 64 + half * 32 + row) * DM + 512 + h * 64 + pc) = *(const LAS u32x4*)(stg + row * MS + pc); }
    LDS_WAIT();
}
#undef FRAGP
__device__ __forceinline__ void finalize_phase(const Params& p, int gw, int ngw, int lane) {
    const bf16_t* Y = (const bf16_t*)(p.ws + WS_Y); const bf16_t* G = (const bf16_t*)(p.ws + WS_G);
    const h16* SC = (const h16*)(p.ws + WS_SC); const float* SS = (const float*)(p.ws + WS_SS); bf16_t* MIX = (bf16_t*)(p.ws + WS_MIX);
    for (int it = gw; it < MTOK * 2; it += ngw) {
        const int m = it >> 1, h = (it & 1) * 4 + (lane >> 4), cc = (lane & 15) * 4, c = h * 64 + cc, b = m >> 13, tin = m & 8191;
        const u32x2 yw = *(const u32x2*)(Y + (size_t)m * 512 + c), gw2 = *(const u32x2*)(G + (size_t)m * 512 + c);
        const h16x4 v4 = *(const h16x4*)(SC + ((size_t)(b * 8 + h) * SEQ + tin) * 384 + 5 * 64 + cc);
        const float bon = SS[((size_t)(b * 8 + h) * SEQ + tin) * 4 + 2];
        const f32x4 lg = *(const f32x4*)(p.lnx_g + c), lb = *(const f32x4*)(p.lnx_b + c);
        const f32x4 y = {bflo(yw.x), bfhi(yw.x), bflo(yw.y), bfhi(yw.y)}, g = {bflo(gw2.x), bfhi(gw2.x), bflo(gw2.y), bfhi(gw2.y)};
        float s = (y.x + y.y) + (y.z + y.w); s = row16_sum(s);
        const float mean = s * (1.f / 64.f); const f32x4 d = y - mean;
        float q = (d.x * d.x + d.y * d.y) + (d.z * d.z + d.w * d.w); q = row16_sum(q);
        const float rstd = rsqrtf(q * (1.f / 64.f) + 64e-5f);
        const f32x4 vv = {(float)v4[0], (float)v4[1], (float)v4[2], (float)v4[3]};
        const f32x4 o = (d * rstd * lg + lb + vv * bon) * g;
        u32x2 w; w.x = pk2(o.x, o.y); w.y = pk2(o.z, o.w);
        *(u32x2*)(MIX + (size_t)m * DM + c) = w;
    }
}

#define XB_TMO      128
#define XB_XCNT(j)  (256  + 64 * (j))
#define XB_XSUB(j)  (1280 + 64 * (j))
#define XB_XGEN(j)  (2304 + 64 * (j))
#define XB_TOP      3328
#define XB_TOPGEN   3392
#define XCD_BAR_WORDS 3456
#define XB_SPIN_CAP (1u << 18)

__device__ __forceinline__ unsigned xb_ld(unsigned* p)              { return __hip_atomic_load(p, __ATOMIC_RELAXED, __HIP_MEMORY_SCOPE_AGENT); }
__device__ __forceinline__ unsigned xb_add(unsigned* p, unsigned v) { return __hip_atomic_fetch_add(p, v, __ATOMIC_RELAXED, __HIP_MEMORY_SCOPE_AGENT); }
__device__ __forceinline__ unsigned xb_xcc_id() { return (unsigned)__builtin_amdgcn_s_getreg((3 << 11) | 20) & 0xFu; }
#define XB_SPIN(cond, bar) do { unsigned _sp = 0; while (cond) { __builtin_amdgcn_s_sleep(1); \
    if ((++_sp & 255u) == 0u) { if (xb_ld(&(bar)[XB_TMO])) break; if (_sp > XB_SPIN_CAP) { atomicAdd(&(bar)[XB_TMO], 1u); break; } } } } while (0)

struct XcdBarrier {
    unsigned w0;
    unsigned* bar; unsigned x;
    volatile LAS unsigned* st;
};

__device__ __forceinline__ XcdBarrier xcd_barrier_post(unsigned* bar, volatile LAS unsigned* st, unsigned w0) {
    XcdBarrier b; b.w0 = w0; b.bar = bar; b.x = xb_xcc_id(); b.st = st;
    if (w0 && lane_now() == 0) (void)xb_add(&bar[XB_XCNT(b.x)], 1u);
    return b;
}
__device__ __forceinline__ void xcd_barrier_complete(unsigned* bar, unsigned x, unsigned& nloc, unsigned& nx) {
    const unsigned G = gridDim.x * gridDim.y * gridDim.z;
    unsigned sum, cnt, mine, sp = 0u;
    for (;;) {
        sum = 0u; cnt = 0u; mine = 0u;
#pragma unroll
        for (unsigned j = 0; j < 16; ++j) { const unsigned c = xb_ld(&bar[XB_XCNT(j)]); sum += c; cnt += (c > 0u) ? 1u : 0u; mine = (j == x) ? c : mine; }
        if (sum == G) break;
        __builtin_amdgcn_s_sleep(1);
        if ((++sp & 255u) == 0u) { if (xb_ld(&bar[XB_TMO])) break; if (sp > XB_SPIN_CAP) { atomicAdd(&bar[XB_TMO], 1u); break; } }
    }
    nloc = mine > 0u ? mine : 1u; nx = cnt > 0u ? cnt : 1u;
}

__device__ __forceinline__ void xcd_barrier(const XcdBarrier& b) {
    asm volatile("s_waitcnt vmcnt(0)" ::: "memory");
    __syncthreads();
    if (b.w0 && lane_now() == 0) {
        unsigned* bar = b.bar;
        __builtin_amdgcn_s_waitcnt(0);
        unsigned nloc = b.st[0], nx = b.st[1];
        if (nloc == 0u) { xcd_barrier_complete(bar, b.x, nloc, nx); b.st[0] = nloc; b.st[1] = nx; }
        const unsigned old = xb_add(&bar[XB_XSUB(b.x)], 1u);
        const unsigned gen = old / nloc;
        if (old + 1u == (gen + 1u) * nloc) {
            __builtin_amdgcn_fence(__ATOMIC_RELEASE, "agent");
            asm volatile("s_waitcnt vmcnt(0)" ::: "memory");
            const unsigned og = xb_add(&bar[XB_TOP], 1u);
            const unsigned tg = og / nx;
            if (og + 1u == (tg + 1u) * nx) xb_add(&bar[XB_TOPGEN], 1u);
            else XB_SPIN(xb_ld(&bar[XB_TOPGEN]) == tg, bar);
            __builtin_amdgcn_fence(__ATOMIC_ACQUIRE, "agent");
            xb_add(&bar[XB_XGEN(b.x)], 1u);
            asm volatile("s_waitcnt vmcnt(0)" ::: "memory");
        } else {
            XB_SPIN(xb_ld(&bar[XB_XGEN(b.x)]) == gen, bar);
            __builtin_amdgcn_fence(__ATOMIC_ACQUIRE, "agent");
            asm volatile("s_waitcnt vmcnt(0)" ::: "memory");
        }
    }
    __syncthreads();
}

__global__ void __launch_bounds__(512, 2) mega_fwd(Params p) {
    extern __shared__ __attribute__((aligned(16))) unsigned char lds_raw[];
    cg::grid_group grid = cg::this_grid();
    LAS unsigned char* lds = (LAS unsigned char*)lds_raw;
    const int wave = __builtin_amdgcn_readfirstlane((int)threadIdx.x >> 6);
#define lane (lane_now())
#define tid (wave * 64 + lane_now())
    const int G = gridDim.x, gw = blockIdx.x * 8 + wave, ngw = G * 8;
    unsigned char* ws = p.ws;
    float* mod = (float*)(ws + WS_MOD);
    bf16_t* XN = (bf16_t*)(ws + WS_XN); bf16_t* HID = (bf16_t*)(ws + WS_HID); bf16_t* MIX = (bf16_t*)(ws + WS_MIX);

    { const int t0_ = tid; if (t0_ < 2) *(LAS unsigned*)(lds + LDS_BYTES - 64 + 4 * t0_) = 0u; }
    __syncthreads();
    const XcdBarrier xbar = xcd_barrier_post((unsigned*)(ws + WS_BAR), (volatile LAS unsigned*)(lds + LDS_BYTES - 64), wave == 0 ? 1u : 0u);
    { const int l0_ = lane; p0_convert(p, lds, gw, ngw, wave, l0_); p0_mod(p, lds, wave * 64 + l0_, wave, l0_); }
    grid.sync();
    norm_phase(p.x, p.norm1_g, mod, 0, 1, XN, lds, gw, ngw, wave, lane);
    xcd_barrier(xbar);
    { pg8::Gemm g{XN, (const bf16_t*)(ws + WS_W13_1), MTOK, 2 * DFF, DM}; pg8::StaticOrder S; S.init(MTOK, 2 * DFF, G, (int)blockIdx.x);
      EpiSwiGLU E{HID, DFF}; pg8::gemm_phase<EpiSwiGLU, pg8::StaticOrder, true, true>(lds, g, S, E, wave); }
    xcd_barrier(xbar);
    { pg8::Gemm g{HID, (const bf16_t*)(ws + WS_W2_1), MTOK, DM, DFF}; pg8::StaticOrder S; S.init(MTOK, DM, G, (int)blockIdx.x);
      EpiResid E{p.x, p.out, mod + 2 * 1024, 0.5f}; pg8::gemm_phase<EpiResid, pg8::StaticOrder, true, true>(lds, g, S, E, wave); }
    xcd_barrier(xbar);
    norm_phase(p.out, p.norm2_g, mod, 3, 4, XN, lds, gw, ngw, wave, lane);
    xcd_barrier(xbar);
    { pg8::Gemm g{XN, (const bf16_t*)(ws + WS_WIN), MTOK, NIN, DM}; pg8::StaticOrder S; S.init(MTOK, NIN, G, (int)blockIdx.x);
      EpiProj E{(bf16_t*)(ws + WS_PA), (bf16_t*)(ws + WS_PB)}; pg8::gemm_phase<EpiProj, pg8::StaticOrder, true, true>(lds, g, S, E, wave); }
    xcd_barrier(xbar);
    { const int lane6 = lane; LAS unsigned char* ldsw = lds + wave * 8448;
      prep_rwkv_phase(p, lds, gw, ngw, wave, lane6);
      BAR_LDS();
      for (int it = gw; it < (MTOK / 64) * 8; it += ngw) prep_attn_item(p, ldsw, it, lane6); }
    xcd_barrier(xbar);
    { const int lane7 = lane, tid7 = wave * 64 + lane7;
      h16 raw[48]; if ((int)blockIdx.x < 32 * 128) chunk_load(p, (int)blockIdx.x, tid7, raw);
      for (int it = blockIdx.x; it < 32 * 128; it += G) chunk_pre(p, lds, it, (it + G < 32 * 128) ? it + G : -1, tid7, wave, lane7, raw); }
    xcd_barrier(xbar);
    {
        LAS float* bl = (LAS float*)lds; const int lane8 = lane;
        {
            float gq = 0.f, gk = 0.f;
            for (int i = 0; i < 64; ++i) { gq = fmaxf(gq, fabsf(p.qn_g[i])); gk = fmaxf(gk, fabsf(p.kn_g[i])); }
            const float mb = 8.f * gq * gk * 1.4426950408889634f;
            for (int i = wave * 64 + lane8; i < 8 * 513; i += 512) bl[i] = p.rel_bias[i] * 1.4426950408889634f - mb;
        }
        __syncthreads();
        for (int bh = blockIdx.x; bh < 32; bh += G) chain_head(p, lds, bh, wave, lane8);
        const int lane8a = lane;
        unsigned* qbase = (unsigned*)(ws + WS_QCTR);
        const unsigned myx = xbar.x & 7u;
        for (unsigned qi = 0; qi < 8u; ++qi) {
            const unsigned qx = (myx + qi) & 7u; unsigned* qctr = qbase + 64 * qx;
            for (;;) {
                unsigned u = 0u;
                if (lane8a == 0) u = __hip_atomic_fetch_add(qctr, 1u, __ATOMIC_RELAXED, __HIP_MEMORY_SCOPE_AGENT);
                u = (unsigned)__builtin_amdgcn_readfirstlane((int)u);
                if (u >= 4u * 256u) break;
                attn_unit(p, bl, (LAS bf16_t*)(lds + 73728 + wave * (32 * MS * 2)), (int)(((qx + 8u * (u >> 8)) << 8) | (u & 255u)), lane8a);
            }
        }
    }
    xcd_barrier(xbar);
    { const int lane9 = lane; LAS unsigned char* ldsw = lds + wave * (16 * MS * 2); for (int it = gw; it < 32 * 128; it += ngw) rwkv_out_ch(p, ldsw, it, lane9); }
    xcd_barrier(xbar);
    { pg8::Gemm g{MIX, (const bf16_t*)(ws + WS_WOUT), MTOK, DM, DM}; pg8::StaticOrder S; S.init(MTOK, DM, G, (int)blockIdx.x);
      EpiResid E{p.out, p.out, mod + 5 * 1024, 1.0f}; pg8::gemm_phase<EpiResid, pg8::StaticOrder, true, true>(lds, g, S, E, wave); }
    xcd_barrier(xbar);
    norm_phase(p.out, p.norm3_g, mod, 6, 7, XN, lds, gw, ngw, wave, lane);
    xcd_barrier(xbar);
    { pg8::Gemm g{XN, (const bf16_t*)(ws + WS_W13_2), MTOK, 2 * DFF, DM}; pg8::StaticOrder S; S.init(MTOK, 2 * DFF, G, (int)blockIdx.x);
      EpiSwiGLU E{HID, DFF}; pg8::gemm_phase<EpiSwiGLU, pg8::StaticOrder, true, true>(lds, g, S, E, wave); }
    xcd_barrier(xbar);
    { pg8::Gemm g{HID, (const bf16_t*)(ws + WS_W2_2), MTOK, DM, DFF}; pg8::StaticOrder S; S.init(MTOK, DM, G, (int)blockIdx.x);
      EpiResid E{p.out, p.out, mod + 8 * 1024, 0.5f}; pg8::gemm_phase<EpiResid, pg8::StaticOrder, true, true>(lds, g, S, E, wave); }
}

#undef lane
#undef tid
extern "C" void kernel_launch(void* const* d_in, const int* in_sizes, int n_in, void* d_out, int out_size, void* d_ws, size_t ws_size, hipStream_t stream) {
    static int grid = 0;
    if (grid == 0) {
        if (n_in != 29 || in_sizes[0] != MTOK * DM || out_size != MTOK * DM || ws_size < WS_END) {
            fprintf(stderr, "kernel_launch: unexpected shapes/workspace (n_in %d, in0 %d, out %d, ws %zu)\n", n_in, n_in > 0 ? in_sizes[0] : -1, out_size, ws_size); grid = -1; return; }
        int dev = 0, cus = 0, per_cu = 0;
        hipGetDevice(&dev); hipDeviceGetAttribute(&cus, hipDeviceAttributeMultiprocessorCount, dev);
        if (hipFuncSetAttribute((const void*)mega_fwd, hipFuncAttributeMaxDynamicSharedMemorySize, LDS_BYTES) != hipSuccess) { fprintf(stderr, "kernel_launch: hipFuncSetAttribute failed\n"); grid = -1; return; }
        if (hipOccupancyMaxActiveBlocksPerMultiprocessor(&per_cu, (const void*)mega_fwd, 512, LDS_BYTES) != hipSuccess || per_cu < 1) { fprintf(stderr, "kernel_launch: occupancy query says %d\n", per_cu); per_cu = 1; }
        (void)hipGetLastError();
        grid = cus * per_cu;
    }
    if (grid < 0) return;
    if (hipMemsetAsync((char*)d_ws + 512 * 1024, 0, 512 * 1024, stream) != hipSuccess) { fprintf(stderr, "kernel_launch: memset failed\n"); return; }
    Params p{};
    const float** pp = (const float**)&p;
    for (int i = 0; i < 29; ++i) pp[i] = (const float*)d_in[i];
    p.out = (float*)d_out; p.ws = (unsigned char*)d_ws;
    void* args[] = {&p};
    hipError_t e = hipLaunchCooperativeKernel((const void*)mega_fwd, dim3(grid), dim3(512), args, LDS_BYTES, stream);
    if (e != hipSuccess) fprintf(stderr, "cooperative launch failed: %s (grid %d)\n", hipGetErrorString(e), grid);
}
```

```cpp
#include <hip/hip_runtime.h>
#include <hip/hip_cooperative_groups.h>
#include <cstdio>
#include <cstdint>
namespace cg = cooperative_groups;
__device__ __forceinline__ int lane_now() { int l; asm volatile("v_mbcnt_lo_u32_b32 %0, -1, 0\n\tv_mbcnt_hi_u32_b32 %0, -1, %0" : "=v"(l)); return l; }
namespace pg8 {
#define PG8_LAS __attribute__((address_space(3)))
typedef unsigned short bf16_t;
typedef short bf16x8 __attribute__((ext_vector_type(8)));
typedef float f32x4 __attribute__((ext_vector_type(4)));
typedef unsigned u32x4 __attribute__((ext_vector_type(4)));
constexpr int BM = 256, BK = 64, HALF = 128, HTB = HALF * BK * 2  , STAGE_BYTES = 8 * HTB, NXCD = 8, WGM = 8;

__host__ __device__ __forceinline__ int lds_byte(int r, int c) { const int st = (r >> 4) * 2 + (c >> 5), rr = r & 15, cc = c & 31, ob = rr * 64 + cc * 2; return st * 1024 + (ob ^ (((ob >> 9) & 1) << 5)); }
__host__ __device__ __forceinline__ void stage_rc(int b, int& R, int& C) { const int st = b / 1024, sb = b % 1024, swz = sb ^ (((sb >> 9) & 1) << 5); R = (st >> 1) * 16 + swz / 64; C = (st & 1) * 32 + (swz % 64) / 2; }
__host__ __device__ __forceinline__ int perm32(int rho) { const int n = rho >> 4, i = rho & 15; return 8 * (i >> 2) + 4 * n + (i & 3); }

struct Unit { int pm, pn; };
struct Gemm { const bf16_t* A; const bf16_t* Bt; int M, N, K; };

struct StaticOrder {
    int nM, nN, nwg, G, c;
    __host__ __device__ void init(int M, int N, int G_, int c_) { nM = M / BM; nN = N / BM; nwg = nM * nN; G = G_; c = c_; }
    __host__ __device__ bool next(int i, Unit& u) const {
        const long L = (long)i * G + c; if (L >= nwg) return false;
        int wgid = (int)L; { const int q = nwg / NXCD, r = nwg % NXCD, xcd = wgid % NXCD, off = wgid / NXCD; wgid = (xcd < r ? xcd * (q + 1) : r * (q + 1) + (xcd - r) * q) + off; }
        const int nig = WGM * nN, gid = wgid / nig, fm = gid * WGM, gsz = (nM - fm) < WGM ? (nM - fm) : WGM;
        u.pm = fm + ((wgid % nig) % gsz); u.pn = (wgid % nig) / gsz; return true;
    }
    __device__ __forceinline__ void a_ready(const Unit&) const {}
    __device__ __forceinline__ void done(const Unit&) const {}
};

__device__ __forceinline__ unsigned cvt_pk_bf16(float lo, float hi) { unsigned r; asm volatile("v_cvt_pk_bf16_f32 %0, %1, %2" : "=v"(r) : "v"(lo), "v"(hi)); return r; }
typedef float f32x2 __attribute__((ext_vector_type(2)));
template <class Epi, class Sched, bool ALIGN_EPI = false, bool SP2 = false>
__device__ __forceinline__ void gemm_phase(PG8_LAS unsigned char* lds, const Gemm g, const Sched& S, const Epi& E, const int wid) {
    const int lane = lane_now(), tid = wid * 64 + lane, wr = wid >> 2, wc = wid & 3, fr = lane & 15, fq = lane >> 4;
    const int K = g.K, nt = K / BK;
    unsigned voffA[2], voffB[2];
#pragma unroll
    for (int i = 0; i < 2; ++i) { int R, C; stage_rc(tid * 16 + i * 8192, R, C); const int Rb = Epi::PERM ? ((R & ~31) + perm32(R & 31)) : R;
        voffA[i] = (unsigned)(R * K + C) * 2u; voffB[i] = (unsigned)(Rb * K + C) * 2u; }
    const size_t kstep = (size_t)(BK * 2);
    const size_t hstep = (size_t)HALF * K * 2;
    const size_t tstep = 2 * hstep;
    const unsigned ldsw = (unsigned)wid * 1024u;
    const int aoff = lds_byte(wr * 64 + fr, fq * 8), boff = lds_byte(wc * 32 + fr, fq * 8);
#define PG8_SA(b, h) (((b) * 2 + (h)) * HTB)
#define PG8_SB(b, h) ((4 + (b) * 2 + (h)) * HTB)
#define PG8_STAGE(bufoff, gbase, voff) do { _Pragma("unroll") for (int _i = 0; _i < 2; ++_i) \
        __builtin_amdgcn_global_load_lds((const unsigned*)((const char*)(gbase) + (voff)[_i]), (PG8_LAS unsigned*)(lds + (bufoff) + ldsw + _i * 8192), 16, 0, 0); } while (0)
#define PG8_LDA(dst, b, h) do { _Pragma("unroll") for (int m = 0; m < 4; ++m) _Pragma("unroll") for (int k = 0; k < 2; ++k) dst[m][k] = *(const PG8_LAS bf16x8*)(lds + PG8_SA(b, h) + aoff + m * 2048 + k * 1024); } while (0)
#define PG8_LDB(dst, b, h) do { _Pragma("unroll") for (int n = 0; n < 2; ++n) _Pragma("unroll") for (int k = 0; k < 2; ++k) dst[n][k] = *(const PG8_LAS bf16x8*)(lds + PG8_SB(b, h) + boff + n * 2048 + k * 1024); } while (0)
#define PG8_MMA(ai, bj, At, Bt) do { __builtin_amdgcn_s_setprio(1); _Pragma("unroll") for (int m = 0; m < 4; ++m) _Pragma("unroll") for (int n = 0; n < 2; ++n) _Pragma("unroll") for (int k = 0; k < 2; ++k) \
        acc[ai][bj][m][n] = __builtin_amdgcn_mfma_f32_16x16x32_bf16(Bt[n][k], At[m][k], acc[ai][bj][m][n], 0, 0, 0); __builtin_amdgcn_s_setprio(0); } while (0)
#define PG8_WAIT_V(n) asm volatile("s_waitcnt vmcnt(" #n ")" ::: "memory")
#define PG8_WAIT_L(n) asm volatile("s_waitcnt lgkmcnt(" #n ")" ::: "memory")
#define PG8_BAR __builtin_amdgcn_s_barrier()
#define PG8_SCHED __builtin_amdgcn_sched_barrier(0)
    Unit cur, nxt; int ui = 0;
    if (!S.next(0, cur)) return;
    f32x4 acc[2][2][4][2];
#pragma unroll
    for (int a = 0; a < 2; ++a)
#pragma unroll
        for (int b = 0; b < 2; ++b)
#pragma unroll
            for (int m = 0; m < 4; ++m)
#pragma unroll
                for (int n = 0; n < 2; ++n) acc[a][b][m][n] = (f32x4){0.f, 0.f, 0.f, 0.f};
    bf16x8 At[4][2], B0[2][2], B1[2][2];
    const char* cA = (const char*)g.A + (size_t)cur.pm * tstep; const char* cB = (const char*)g.Bt + (size_t)cur.pn * tstep;
    S.a_ready(cur);
    if constexpr (SP2) {
        PG8_STAGE(PG8_SB(0, 0), cB, voffB); PG8_STAGE(PG8_SB(0, 1), cB + hstep, voffB); PG8_STAGE(PG8_SA(0, 0), cA, voffA); PG8_STAGE(PG8_SA(0, 1), cA + hstep, voffA);
        if (wr == 1) PG8_BAR;
        PG8_WAIT_V(2); PG8_BAR;
        PG8_STAGE(PG8_SB(1, 0), cB + kstep, voffB); PG8_STAGE(PG8_SA(1, 0), cA + kstep, voffA); PG8_STAGE(PG8_SB(1, 1), cB + hstep + kstep, voffB);
        PG8_WAIT_V(6); PG8_BAR;
    } else {
        PG8_STAGE(PG8_SB(0, 0), cB, voffB); PG8_STAGE(PG8_SA(0, 0), cA, voffA); PG8_STAGE(PG8_SB(0, 1), cB + hstep, voffB); PG8_STAGE(PG8_SA(0, 1), cA + hstep, voffA);
        if (wr == 1) PG8_BAR;
        PG8_WAIT_V(4); PG8_BAR;
        PG8_STAGE(PG8_SB(1, 0), cB + kstep, voffB); PG8_STAGE(PG8_SA(1, 0), cA + kstep, voffA); PG8_STAGE(PG8_SB(1, 1), cB + hstep + kstep, voffB);
        PG8_WAIT_V(6); PG8_BAR;
    }
    for (;;) {
        const bool has_next = S.next(ui + 1, nxt);
        const char* nA = has_next ? (const char*)g.A + (size_t)nxt.pm * tstep : cA; const char* nB = has_next ? (const char*)g.Bt + (size_t)nxt.pn * tstep : cB;
        for (int t = 0; t < nt; t += 2) {
            const bool last = (t == nt - 2);
            const char* a1 = cA + (size_t)(t + 1) * kstep;
            const char* a2 = last ? nA : cA + (size_t)(t + 2) * kstep; const char* b2 = last ? nB : cB + (size_t)(t + 2) * kstep;
            const char* a3 = a2 + kstep; const char* b3 = b2 + kstep;
            if (last && has_next) S.a_ready(nxt);
            if constexpr (SP2) {
            PG8_LDB(B0, 0, 0); PG8_LDB(B1, 0, 1); PG8_SCHED; PG8_LDA(At, 0, 0); PG8_STAGE(PG8_SA(1, 1), a1 + hstep, voffA);
            PG8_WAIT_V(8); PG8_WAIT_L(0); PG8_BAR; PG8_MMA(0, 0, At, B0); PG8_MMA(0, 1, At, B1); PG8_BAR; PG8_SCHED;
            PG8_LDA(At, 0, 1); PG8_STAGE(PG8_SB(0, 0), b2, voffB); PG8_STAGE(PG8_SB(0, 1), b2 + hstep, voffB); PG8_STAGE(PG8_SA(0, 0), a2, voffA);
            PG8_WAIT_V(8); PG8_WAIT_L(0); PG8_BAR; PG8_MMA(1, 0, At, B0); PG8_MMA(1, 1, At, B1); PG8_BAR; PG8_SCHED;
            PG8_LDB(B0, 1, 0); PG8_LDB(B1, 1, 1); PG8_SCHED; PG8_LDA(At, 1, 0); PG8_STAGE(PG8_SA(0, 1), a2 + hstep, voffA);
            PG8_WAIT_V(8); PG8_WAIT_L(0); PG8_BAR; PG8_MMA(0, 0, At, B0); PG8_MMA(0, 1, At, B1); PG8_BAR; PG8_SCHED;
            PG8_LDA(At, 1, 1); PG8_STAGE(PG8_SB(1, 0), b3, voffB); PG8_STAGE(PG8_SB(1, 1), b3 + hstep, voffB); PG8_STAGE(PG8_SA(1, 0), a3, voffA);
            PG8_WAIT_V(8); PG8_WAIT_L(0); PG8_BAR; PG8_MMA(1, 0, At, B0); PG8_MMA(1, 1, At, B1); PG8_BAR; PG8_SCHED;
            } else {
            PG8_LDB(B0, 0, 0); PG8_SCHED; PG8_LDA(At, 0, 0); PG8_STAGE(PG8_SA(1, 1), a1 + hstep, voffA);
            PG8_WAIT_L(8); PG8_BAR; PG8_WAIT_L(0); PG8_MMA(0, 0, At, B0); PG8_BAR; PG8_SCHED;
            PG8_LDB(B1, 0, 1); PG8_STAGE(PG8_SB(0, 0), b2, voffB);
            PG8_BAR; PG8_WAIT_L(0); PG8_MMA(0, 1, At, B1); PG8_BAR;
            PG8_LDA(At, 0, 1); PG8_STAGE(PG8_SA(0, 0), a2, voffA);
            PG8_BAR; PG8_WAIT_L(0); PG8_MMA(1, 0, At, B0); PG8_BAR; PG8_SCHED;
            PG8_STAGE(PG8_SB(0, 1), b2 + hstep, voffB);
            PG8_WAIT_V(6); PG8_BAR; PG8_MMA(1, 1, At, B1); PG8_BAR;
            PG8_LDB(B0, 1, 0); PG8_SCHED; PG8_LDA(At, 1, 0); PG8_STAGE(PG8_SA(0, 1), a2 + hstep, voffA);
            PG8_WAIT_L(8); PG8_BAR; PG8_WAIT_L(0); PG8_MMA(0, 0, At, B0); PG8_BAR; PG8_SCHED;
            PG8_LDB(B1, 1, 1); PG8_STAGE(PG8_SB(1, 0), b3, voffB);
            PG8_BAR; PG8_WAIT_L(0); PG8_MMA(0, 1, At, B1); PG8_BAR;
            PG8_LDA(At, 1, 1); PG8_STAGE(PG8_SA(1, 0), a3, voffA);
            PG8_BAR; PG8_WAIT_L(0); PG8_MMA(1, 0, At, B0); PG8_BAR; PG8_SCHED;
            PG8_STAGE(PG8_SB(1, 1), b3 + hstep, voffB);
            PG8_WAIT_V(6); PG8_BAR; PG8_MMA(1, 1, At, B1); PG8_BAR;
            }
        }
        if constexpr (ALIGN_EPI) { if (wr == 0) PG8_BAR; }
        if constexpr (!Epi::AFTER_DRAIN) { E(acc, cur, wr, wc, fr, fq); S.done(cur); }
        if (!has_next) break;
#pragma unroll
        for (int a = 0; a < 2; ++a)
#pragma unroll
            for (int b = 0; b < 2; ++b)
#pragma unroll
                for (int m = 0; m < 4; ++m)
#pragma unroll
                    for (int n = 0; n < 2; ++n) acc[a][b][m][n] = (f32x4){0.f, 0.f, 0.f, 0.f};
        cur = nxt; cA = nA; cB = nB; ++ui;
        if constexpr (ALIGN_EPI) { if (wr == 1) PG8_BAR; }
    }
    PG8_WAIT_V(0);
    if constexpr (!ALIGN_EPI) { if (wr == 0) PG8_BAR; }
    PG8_BAR;
    if constexpr (Epi::AFTER_DRAIN) { E.fused(acc, cur, wr, wc, fr, fq, lds, wid, lane); S.done(cur); }
#undef PG8_SA
#undef PG8_SB
#undef PG8_STAGE
#undef PG8_LDA
#undef PG8_LDB
#undef PG8_MMA
#undef PG8_WAIT_V
#undef PG8_WAIT_L
#undef PG8_BAR
#undef PG8_SCHED
}
}

constexpr int BATCH = 4, SEQ = 8192, DM = 1024, MTOK = BATCH * SEQ, DFF = 2816, NPA = 1792, NPB = 1536, NIN = 3328, NMOD = 9 * 1024;
constexpr size_t MiB = 1u << 20;
constexpr size_t WS_MOD = 0;
constexpr size_t WS_QCTR = 512 * 1024;
constexpr size_t WS_BAR = 768 * 1024;
constexpr size_t WS_W = 1 * MiB;
constexpr size_t WS_W13_1 = WS_W, WS_W2_1 = WS_W13_1 + 11 * MiB, WS_W13_2 = WS_W2_1 + 11 * MiB / 2, WS_W2_2 = WS_W13_2 + 11 * MiB;
constexpr size_t WS_WIN = WS_W2_2 + 11 * MiB / 2, WS_WOUT = WS_WIN + 13 * MiB / 2, WS_WDU = WS_WOUT + 2 * MiB, WS_WAU = WS_WDU + 65536, WS_WGU = WS_WAU + 65536;
constexpr size_t WS_XN = 43 * MiB;
constexpr size_t WS_G = WS_XN, WS_SS = WS_XN + 32 * MiB;
constexpr size_t WS_PA = 107 * MiB;
constexpr size_t WS_PB = 219 * MiB;
constexpr size_t WS_HID = WS_PA;
constexpr size_t WS_MIX = WS_PA;
constexpr size_t WS_Y = WS_PA + 64 * MiB;
constexpr size_t WS_SC = 315 * MiB;
constexpr size_t WS_END = 507 * MiB;
static_assert(WS_WGU + 131072 <= WS_XN && WS_Y + 32 * MiB <= WS_PB && WS_HID + (size_t)MTOK * DFF * 2 <= WS_SC && WS_PB + 96 * MiB == WS_SC, "ws map");
constexpr int LDS_BYTES = 147456;

#define LAS __attribute__((address_space(3)))
typedef unsigned short bf16_t;
typedef float f32x4 __attribute__((ext_vector_type(4)));
typedef float f32x16 __attribute__((ext_vector_type(16)));
typedef unsigned u32x4 __attribute__((ext_vector_type(4)));
typedef unsigned u32x2 __attribute__((ext_vector_type(2)));
typedef short bf16x8 __attribute__((ext_vector_type(8)));
typedef _Float16 h16;
typedef _Float16 h16x4 __attribute__((ext_vector_type(4)));
typedef _Float16 h16x8 __attribute__((ext_vector_type(8)));

#define LDS_WAIT() asm volatile("s_waitcnt lgkmcnt(0)" ::: "memory")
#define BAR_LDS() do { asm volatile("s_waitcnt lgkmcnt(0)" ::: "memory"); __builtin_amdgcn_s_barrier(); asm volatile("" ::: "memory"); } while (0)
typedef float f32x2c __attribute__((ext_vector_type(2))); typedef __bf16 bf16x2c __attribute__((ext_vector_type(2)));
__device__ __forceinline__ unsigned pk2(float lo, float hi) { const f32x2c v = {lo, hi}; const bf16x2c b = __builtin_convertvector(v, bf16x2c); return __builtin_bit_cast(unsigned, b); }
__device__ __forceinline__ float bflo(unsigned w) { return __uint_as_float(w << 16); }
__device__ __forceinline__ float bfhi(unsigned w) { return __uint_as_float(w & 0xffff0000u); }
__device__ __forceinline__ float fast_sigmoid(float x) { return __builtin_amdgcn_rcpf(1.f + __expf(-x)); }
__device__ __forceinline__ float silu_f(float x) { return x * fast_sigmoid(x); }
__device__ __forceinline__ float wave_sum(float v) {
#pragma unroll
    for (int o = 1; o < 64; o <<= 1) v += __shfl_xor(v, o);
    return v;
}
template <int CTRL> __device__ __forceinline__ float dpp_f(float x) { return __builtin_bit_cast(float, __builtin_amdgcn_mov_dpp(__builtin_bit_cast(int, x), CTRL, 0xf, 0xf, true)); }
__device__ __forceinline__ float row16_sum(float x) {
    x += dpp_f<0xB1>(x); x += dpp_f<0x4E>(x); x += dpp_f<0x141>(x); x += dpp_f<0x128>(x); return x;
}

struct EpiSwiGLU {
    static constexpr bool PERM = true, AFTER_DRAIN = false;
    bf16_t* O; int ldc;
    __device__ __forceinline__ void operator()(const f32x4 (&acc)[2][2][4][2], const pg8::Unit& u, int wr, int wc, int fr, int fq) const {
        const int row0 = u.pm * 256 + wr * 64 + fr, col0 = u.pn * 128 + wc * 32 + 8 * fq;
#pragma unroll
        for (int ai = 0; ai < 2; ++ai)
#pragma unroll
            for (int m = 0; m < 4; ++m) {
                bf16_t* rowp = O + (size_t)(row0 + ai * 128 + m * 16) * ldc + col0;
                const f32x4 a0 = acc[ai][0][m][0], a1 = acc[ai][0][m][1], b0 = acc[ai][1][m][0], b1 = acc[ai][1][m][1];
                u32x4 w;
                w.x = pk2(silu_f(a0[0]) * b0[0], silu_f(a0[1]) * b0[1]); w.y = pk2(silu_f(a0[2]) * b0[2], silu_f(a0[3]) * b0[3]);
                w.z = pk2(silu_f(a1[0]) * b1[0], silu_f(a1[1]) * b1[1]); w.w = pk2(silu_f(a1[2]) * b1[2], silu_f(a1[3]) * b1[3]);
                *(u32x4*)rowp = w;
            }
    }
};
struct EpiResid {
    static constexpr bool PERM = true, AFTER_DRAIN = false;
    const float* base; float* out; const float* gate; float coef;
    __device__ __forceinline__ void operator()(const f32x4 (&acc)[2][2][4][2], const pg8::Unit& u, int wr, int wc, int fr, int fq) const {
        const int row0 = u.pm * 256 + wr * 64 + fr; const float* gp = gate + (size_t)(u.pm >> 5) * NMOD;
#pragma unroll
        for (int bj = 0; bj < 2; ++bj) {
            const int col = u.pn * 256 + bj * 128 + wc * 32 + 8 * fq;
            const f32x4 g0 = *(const f32x4*)(gp + col) * coef, g1 = *(const f32x4*)(gp + col + 4) * coef;
#pragma unroll
            for (int ai = 0; ai < 2; ++ai)
#pragma unroll
                for (int m = 0; m < 4; ++m) {
                    const size_t off = (size_t)(row0 + ai * 128 + m * 16) * DM + col;
                    const f32x4 x0 = *(const f32x4*)(base + off), x1 = *(const f32x4*)(base + off + 4);
                    *(f32x4*)(out + off) = x0 + g0 * acc[ai][bj][m][0]; *(f32x4*)(out + off + 4) = x1 + g1 * acc[ai][bj][m][1];
                    if (m & 1) asm volatile("" ::: "memory");
                }
        }
    }
};
struct EpiProj {
    static constexpr bool PERM = true, AFTER_DRAIN = false;
    bf16_t* PA; bf16_t* PB;
    __device__ __forceinline__ void operator()(const f32x4 (&acc)[2][2][4][2], const pg8::Unit& u, int wr, int wc, int fr, int fq) const {
        const int row0 = u.pm * 256 + wr * 64 + fr; int colt = u.pn * 256; bf16_t* bp = PA; int ld = NPA;
        if (colt >= NPA) { bp = PB; ld = NPB; colt -= NPA; }
        const int col0 = colt + wc * 32 + 8 * fq;
#pragma unroll
        for (int ai = 0; ai < 2; ++ai)
#pragma unroll
            for (int m = 0; m < 4; ++m) {
                bf16_t* rowp = bp + (size_t)(row0 + ai * 128 + m * 16) * ld + col0;
#pragma unroll
                for (int bj = 0; bj < 2; ++bj) {
                    const f32x4 v0 = acc[ai][bj][m][0], v1 = acc[ai][bj][m][1];
                    u32x4 w; w.x = pk2(v0[0], v0[1]); w.y = pk2(v0[2], v0[3]); w.z = pk2(v1[0], v1[1]); w.w = pk2(v1[2], v1[3]);
                    *(u32x4*)(rowp + bj * 128) = w;
                }
            }
    }
};

struct Params {
    const float *x, *c, *w_ada, *b_ada, *norm1_g, *f1w1, *f1w3, *f1w2, *norm2_g, *w_in, *mu, *w0, *wdu, *a0, *wau, *wgu, *k_k, *k_a, *r_k, *lnx_g, *lnx_b,
        *qn_g, *kn_g, *rel_bias, *w_out, *norm3_g, *f2w1, *f2w3, *f2w2;
    float* out; unsigned char* ws;
};

__device__ __forceinline__ int pi64(int cc) { return ((cc >> 2) & 3) * 16 + (cc >> 4) * 4 + (cc & 3); }
__device__ __forceinline__ void transpose_item(const float* W, int K, int N, bf16_t* WT, int k0, int n0, int drow0, LAS float* scr, int lane, bool perm = false) {
#pragma unroll
    for (int i = 0; i < 8; ++i) { const int kk = 8 * i + (lane >> 3), c4 = 4 * (lane & 7);
        const f32x4 v = *(const f32x4*)(W + (size_t)(k0 + kk) * N + n0 + c4);
        scr[kk * 33 + c4] = v.x; scr[kk * 33 + c4 + 1] = v.y; scr[kk * 33 + c4 + 2] = v.z; scr[kk * 33 + c4 + 3] = v.w; }
    LDS_WAIT();
    const int c = lane & 7;
#pragma unroll
    for (int j = 0; j < 4; ++j) { const int n = (lane >> 3) + 8 * j; const LAS float* s = scr + (8 * c) * 33 + n;
        u32x4 o; o.x = pk2(s[0 * 33], s[1 * 33]); o.y = pk2(s[2 * 33], s[3 * 33]); o.z = pk2(s[4 * 33], s[5 * 33]); o.w = pk2(s[6 * 33], s[7 * 33]);
        const int dr = perm ? (((drow0 + n) & ~63) + pi64((drow0 + n) & 63)) : drow0 + n;
        *(u32x4*)(WT + (size_t)dr * K + k0 + 8 * c) = o; }
    LDS_WAIT();
}
__device__ __forceinline__ void p0_convert(const Params& p, LAS unsigned char* lds, int gw, int ngw, int wave, int lane) {
    LAS float* scr = (LAS float*)(lds + wave * 8448);
    unsigned char* ws = p.ws;
    constexpr int I13 = 16 * 88, I2 = 44 * 32, IIN = 16 * 104, IOUT = 16 * 32, IDU = 16, IGU = 32;
    constexpr int NITEMS = 4 * I13 + 2 * I2 + IIN + IOUT + 2 * IDU + IGU;
    for (int it = gw; it < NITEMS; it += ngw) {
        int r = it;
#define W13_ITEM(src, dst, which) { const int kb = r / 88, nb = r % 88, n0 = nb * 32; transpose_item(src, 1024, DFF, (bf16_t*)(ws + dst), kb * 64, n0, (n0 >> 7) * 256 + which * 128 + (n0 & 127), scr, lane); continue; }
#define WPL_ITEM(src, dst, K_, N_) { const int nbn = N_ / 32, kb = r / nbn, nb = r % nbn; transpose_item(src, K_, N_, (bf16_t*)(ws + dst), kb * 64, nb * 32, nb * 32, scr, lane); continue; }
        if (r < I13) W13_ITEM(p.f1w1, WS_W13_1, 0) r -= I13;
        if (r < I13) W13_ITEM(p.f1w3, WS_W13_1, 1) r -= I13;
        if (r < I13) W13_ITEM(p.f2w1, WS_W13_2, 0) r -= I13;
        if (r < I13) W13_ITEM(p.f2w3, WS_W13_2, 1) r -= I13;
        if (r < I2) WPL_ITEM(p.f1w2, WS_W2_1, DFF, 1024) r -= I2;
        if (r < I2) WPL_ITEM(p.f2w2, WS_W2_2, DFF, 1024) r -= I2;
        if (r < IIN) { const int kb = r / 104, nb = r % 104; transpose_item(p.w_in, 1024, NIN, (bf16_t*)(ws + WS_WIN), kb * 64, nb * 32, nb * 32, scr, lane, nb * 32 < 1536); continue; } r -= IIN;
        if (r < IOUT) WPL_ITEM(p.w_out, WS_WOUT, 1024, 1024) r -= IOUT;
        if (r < IDU) WPL_ITEM(p.wdu, WS_WDU, 64, 512) r -= IDU;
        if (r < IDU) WPL_ITEM(p.wau, WS_WAU, 64, 512) r -= IDU;
        WPL_ITEM(p.wgu, WS_WGU, 128, 512)
#undef W13_ITEM
#undef WPL_ITEM
    }
}
__device__ __forceinline__ void p0_mod(const Params& p, LAS unsigned char* lds, int tid, int wave, int lane) {
    LAS float* sc = (LAS float*)(lds + 69632);
    LAS float* red = (LAS float*)(lds + 69632 + 16384);
    float* mod = (float*)(p.ws + WS_MOD);
    for (int i = tid; i < 4096; i += 512) sc[i] = silu_f(p.c[i]);
    __syncthreads();
    for (int item = blockIdx.x; item < NMOD / 32; item += gridDim.x) {
        const int col = lane & 31, ks = wave * 2 + (lane >> 5), k0 = ks * 64, n = item * 32 + col;
        float a0 = 0.f, a1 = 0.f, a2 = 0.f, a3 = 0.f;
#pragma unroll 8
        for (int kk = 0; kk < 64; ++kk) { const int k = k0 + kk; const float w = p.w_ada[(size_t)k * NMOD + n];
            a0 += sc[k] * w; a1 += sc[1024 + k] * w; a2 += sc[2048 + k] * w; a3 += sc[3072 + k] * w; }
        red[(ks * 4 + 0) * 32 + col] = a0; red[(ks * 4 + 1) * 32 + col] = a1; red[(ks * 4 + 2) * 32 + col] = a2; red[(ks * 4 + 3) * 32 + col] = a3;
        __syncthreads();
        if (tid < 128) { const int b = tid >> 5, cc = tid & 31; float s = p.b_ada[item * 32 + cc];
#pragma unroll
            for (int q = 0; q < 16; ++q) s += red[(q * 4 + b) * 32 + cc];
            mod[(size_t)b * NMOD + item * 32 + cc] = s; }
        __syncthreads();
    }
}

__device__ __forceinline__ void norm_phase(const float* src, const float* g, const float* mod, int ish, int isc, bf16_t* dst, LAS unsigned char* lds, int gw, int ngw, int wave, int lane) {
    LAS float* GSl = (LAS float*)lds; LAS float* SHl = GSl + 4096;
    for (int i = wave * 64 + lane; i < 4096; i += 512) { const int b = i >> 10, c = i & 1023; GSl[i] = g[c] * (1.f + mod[(size_t)b * NMOD + isc * 1024 + c]); SHl[i] = mod[(size_t)b * NMOD + ish * 1024 + c]; }
    BAR_LDS();
    for (int m = gw; m < MTOK; m += ngw) {
        const f32x4* xr = (const f32x4*)(src + (size_t)m * DM) + lane;
        f32x4 v[4]; float s = 0.f;
#pragma unroll
        for (int j = 0; j < 4; ++j) { v[j] = xr[64 * j]; s += (v[j].x * v[j].x + v[j].y * v[j].y) + (v[j].z * v[j].z + v[j].w * v[j].w); }
        s = wave_sum(s);
        const float rstd = rsqrtf(s * (1.f / DM) + 1e-6f);
        const int bo = (m >> 13) * 1024;
        u32x2* o8 = (u32x2*)(dst + (size_t)m * DM) + lane;
#pragma unroll
        for (int j = 0; j < 4; ++j) { const int c = bo + 4 * lane + 256 * j;
            const f32x4 gg = *(const LAS f32x4*)(GSl + c), h4 = *(const LAS f32x4*)(SHl + c);
            const f32x4 o = v[j] * rstd * gg + h4;
            u32x2 w; w.x = pk2(o.x, o.y); w.y = pk2(o.z, o.w); o8[64 * j] = w; }
    }
    BAR_LDS();
}

__device__ __forceinline__ f32x4 lerp4(const bf16_t* cur, const bf16_t* prv, bool first, const float* mu) {
    const u32x2 a = *(const u32x2*)cur; u32x2 q = *(const u32x2*)prv; if (first) { q.x = 0u; q.y = 0u; }
    const f32x4 m = *(const f32x4*)mu;
    const f32x4 x = {bflo(a.x), bfhi(a.x), bflo(a.y), bfhi(a.y)}, y = {bflo(q.x), bfhi(q.x), bflo(q.y), bfhi(q.y)};
    return x + (y - x) * m;
}
constexpr int PREP_PRM = 67584, PREP_WD = PREP_PRM + 16384, PREP_WA = PREP_WD + 9216, PREP_WG = PREP_WA + 9216;
__device__ __forceinline__ void prep_w_load(const Params& p, int h, int tid, u32x4 (&wr)[4]) {
    const bf16_t* Wdu = (const bf16_t*)(p.ws + WS_WDU); const bf16_t* Wau = (const bf16_t*)(p.ws + WS_WAU); const bf16_t* Wgu = (const bf16_t*)(p.ws + WS_WGU);
    wr[0] = *(const u32x4*)(Wdu + (size_t)(h * 64 + (tid >> 3)) * 64 + (tid & 7) * 8);
    wr[1] = *(const u32x4*)(Wau + (size_t)(h * 64 + (tid >> 3)) * 64 + (tid & 7) * 8);
    wr[2] = *(const u32x4*)(Wgu + (size_t)(h * 64 + (tid >> 4)) * 128 + (tid & 15) * 8);
    wr[3] = *(const u32x4*)(Wgu + (size_t)(h * 64 + 32 + (tid >> 4)) * 128 + (tid & 15) * 8);
}
__device__ __forceinline__ void prep_w_store(LAS unsigned char* lds, int tid, const u32x4 (&wr)[4]) {
    *(LAS u32x4*)((LAS bf16_t*)(lds + PREP_WD) + (tid >> 3) * 72 + (tid & 7) * 8) = wr[0];
    *(LAS u32x4*)((LAS bf16_t*)(lds + PREP_WA) + (tid >> 3) * 72 + (tid & 7) * 8) = wr[1];
    *(LAS u32x4*)((LAS bf16_t*)(lds + PREP_WG) + (tid >> 4) * 136 + (tid & 15) * 8) = wr[2];
    *(LAS u32x4*)((LAS bf16_t*)(lds + PREP_WG) + (32 + (tid >> 4)) * 136 + (tid & 15) * 8) = wr[3];
}
__device__ __forceinline__ void prep_rwkv_phase(const Params& p, LAS unsigned char* lds, int gw, int ngw, int wave, int lane) {
    const bf16_t* PA = (const bf16_t*)(p.ws + WS_PA);
    h16* SC = (h16*)(p.ws + WS_SC); float* SS = (float*)(p.ws + WS_SS); bf16_t* G = (bf16_t*)(p.ws + WS_G);
    LAS bf16_t* act = (LAS bf16_t*)(lds + wave * 8448);
    const LAS float* PRM = (const LAS float*)(lds + PREP_PRM);
    const LAS bf16_t* WD = (const LAS bf16_t*)(lds + PREP_WD); const LAS bf16_t* WA = (const LAS bf16_t*)(lds + PREP_WA); const LAS bf16_t* WG = (const LAS bf16_t*)(lds + PREP_WG);
    const int tid = wave * 64 + lane;
    for (int i = tid; i < 4096; i += 512) { const float* src = i < 1536 ? p.mu + i : i < 2048 ? p.w0 + (i - 1536) : i < 2560 ? p.a0 + (i - 2048) : i < 3072 ? p.k_k + (i - 2560) : i < 3584 ? p.k_a + (i - 3072) : p.r_k + (i - 3584);
        ((LAS float*)(lds + PREP_PRM))[i] = *src; }
    BAR_LDS();
    const int ntiles = MTOK / 16, niter = (ntiles + ngw - 1) / ngw;
    for (int kit = 0; kit < niter; ++kit) {
    const int item = gw + kit * ngw; const bool active = item < ntiles;
    const int m0 = (active ? item : 0) * 16, b = m0 >> 13;
    u32x4 wreg[4]; prep_w_load(p, 0, tid, wreg);
    if (active) {
        const int tk = lane >> 2, cq = lane & 3, m = m0 + tk; const bool first = (m & 8191) == 0;
        const bf16_t* pr = PA + (size_t)m * NPA + 1536 + cq * 64; const bf16_t* pp = first ? pr : pr - NPA;
#pragma unroll
        for (int g8 = 0; g8 < 8; ++g8) {
            const f32x4 x0 = lerp4(pr + g8 * 8, pp + g8 * 8, first, p.mu + 1536 + cq * 64 + g8 * 8);
            const f32x4 x1 = lerp4(pr + g8 * 8 + 4, pp + g8 * 8 + 4, first, p.mu + 1536 + cq * 64 + g8 * 8 + 4);
            float v[8] = {x0.x, x0.y, x0.z, x0.w, x1.x, x1.y, x1.z, x1.w};
#pragma unroll
            for (int e = 0; e < 8; ++e) { if (cq == 0) v[e] = 1.f - 2.f * __builtin_amdgcn_rcpf(__expf(2.f * v[e]) + 1.f); else if (cq >= 2) v[e] = fast_sigmoid(v[e]); }
            u32x4 w; w.x = pk2(v[0], v[1]); w.y = pk2(v[2], v[3]); w.z = pk2(v[4], v[5]); w.w = pk2(v[6], v[7]);
            *(LAS u32x4*)(act + tk * 264 + cq * 64 + g8 * 8) = w;
        }
    }
    prep_w_store(lds, tid, wreg);
    BAR_LDS();
    const int fr = lane & 15, fq = lane >> 4;
    const int m = m0 + fr, tin = m & 8191; const bool first = tin == 0;
    const bf16_t* prow = PA + (size_t)m * NPA; const bf16_t* pprev = first ? prow : prow - NPA;
#pragma unroll 1
    for (int h = 0; h < 8; ++h) {
        if (h < 7) prep_w_load(p, h + 1, tid, wreg);
        if (active) {
        {
            f32x4 accG[4];
#pragma unroll
            for (int i = 0; i < 4; ++i) { accG[i] = (f32x4){0.f, 0.f, 0.f, 0.f};
#pragma unroll
                for (int ks = 0; ks < 4; ++ks) {
                    const bf16x8 wg = *(const LAS bf16x8*)(WG + (i * 16 + fr) * 136 + ks * 32 + fq * 8), ag = *(const LAS bf16x8*)(act + fr * 264 + 128 + ks * 32 + fq * 8);
                    accG[i] = __builtin_amdgcn_mfma_f32_16x16x32_bf16(wg, ag, accG[i], 0, 0, 0); } }
#pragma unroll
            for (int hf = 0; hf < 2; ++hf)
                *(u32x4*)(G + (size_t)m * 512 + h * 64 + fq * 16 + hf * 8) = (u32x4){pk2(accG[2 * hf][0], accG[2 * hf][1]), pk2(accG[2 * hf][2], accG[2 * hf][3]), pk2(accG[2 * hf + 1][0], accG[2 * hf + 1][1]), pk2(accG[2 * hf + 1][2], accG[2 * hf + 1][3])};
        }
        f32x4 accD[4], accA[4];
#pragma unroll
        for (int i = 0; i < 4; ++i) {
            accD[i] = (f32x4){0.f, 0.f, 0.f, 0.f}; accA[i] = accD[i];
#pragma unroll
            for (int ks = 0; ks < 2; ++ks) {
                const bf16x8 wd = *(const LAS bf16x8*)(WD + (i * 16 + fr) * 72 + ks * 32 + fq * 8), ad = *(const LAS bf16x8*)(act + fr * 264 + ks * 32 + fq * 8);
                accD[i] = __builtin_amdgcn_mfma_f32_16x16x32_bf16(wd, ad, accD[i], 0, 0, 0);
                const bf16x8 wa = *(const LAS bf16x8*)(WA + (i * 16 + fr) * 72 + ks * 32 + fq * 8), aa = *(const LAS bf16x8*)(act + fr * 264 + 64 + ks * 32 + fq * 8);
                accA[i] = __builtin_amdgcn_mfma_f32_16x16x32_bf16(wa, aa, accA[i], 0, 0, 0);
            }
        }
        float nk = 0.f, sbr = 0.f, skr = 0.f, sbo = 0.f;
        u32x4 kcs[2], kps[2];
#pragma unroll
        for (int hf = 0; hf < 2; ++hf) {
            const int o_ = h * 64 + fq * 16 + hf * 8;
            kcs[hf] = *(const u32x4*)(prow + 512 + o_); kps[hf] = *(const u32x4*)(pprev + 512 + o_); if (first) kps[hf] = (u32x4){0u, 0u, 0u, 0u};
            const u32x4 kc = kcs[hf], kp = kps[hf];
#pragma unroll
            for (int i2 = 0; i2 < 2; ++i2) { const int c = h * 64 + (2 * hf + i2) * 16 + 4 * fq; const f32x4 muk = *(const LAS f32x4*)(PRM + 512 + c), kk4 = *(const LAS f32x4*)(PRM + 2560 + c);
#pragma unroll
                for (int j = 0; j < 4; ++j) { const int e8 = i2 * 4 + j; const unsigned wc_ = kc[e8 >> 1], wp_ = kp[e8 >> 1];
                    const float kcur = (e8 & 1) ? bfhi(wc_) : bflo(wc_), kprv = (e8 & 1) ? bfhi(wp_) : bflo(wp_); const float kr_ = (kcur + (kprv - kcur) * muk[j]) * kk4[j]; nk += kr_ * kr_; } }
        }
        nk += __shfl_xor(nk, 16); nk += __shfl_xor(nk, 32);
        const float inv = 1.f / fmaxf(sqrtf(nk), 1e-12f);
        h16* scp = SC + ((size_t)(b * 8 + h) * SEQ + tin) * 384 + fq * 16;
#pragma unroll
        for (int hf = 0; hf < 2; ++hf) {
            h16x8 owr, odec, ok2, ov, okk, ob;
            const int o_ = h * 64 + fq * 16 + hf * 8;
            const u32x4 rc = *(const u32x4*)(prow + o_), kc = kcs[hf], vc = *(const u32x4*)(prow + 1024 + o_);
            u32x4 rp = *(const u32x4*)(pprev + o_), vp = *(const u32x4*)(pprev + 1024 + o_); const u32x4 kp = kps[hf];
            if (first) { rp = (u32x4){0u, 0u, 0u, 0u}; vp = rp; }
#pragma unroll
            for (int i2 = 0; i2 < 2; ++i2) {
                const int i = 2 * hf + i2, c = h * 64 + i * 16 + 4 * fq;
                const f32x4 mur = *(const LAS f32x4*)(PRM + c), muk = *(const LAS f32x4*)(PRM + 512 + c), muv = *(const LAS f32x4*)(PRM + 1024 + c);
                const f32x4 w04 = *(const LAS f32x4*)(PRM + 1536 + c), a04 = *(const LAS f32x4*)(PRM + 2048 + c), kk4 = *(const LAS f32x4*)(PRM + 2560 + c), ka4 = *(const LAS f32x4*)(PRM + 3072 + c), rk4 = *(const LAS f32x4*)(PRM + 3584 + c);
#pragma unroll
                for (int j = 0; j < 4; ++j) {
                    const int e8 = i2 * 4 + j, e = hf * 8 + e8; const unsigned wsel = (e8 >> 1); const bool hiw = e8 & 1;
#define PREP_GET(arr) ({ const unsigned w_ = arr[wsel]; hiw ? bfhi(w_) : bflo(w_); })
                    const float rcur = PREP_GET(rc), rprv = PREP_GET(rp), kcur = PREP_GET(kc), kprv = PREP_GET(kp), vcur = PREP_GET(vc), vprv = PREP_GET(vp);
#undef PREP_GET
                    const float r = rcur + (rprv - rcur) * mur[j], k = kcur + (kprv - kcur) * muk[j], v = vcur + (vprv - vcur) * muv[j];
                    const float dec = __expf(-0.60653066f * fast_sigmoid(w04[j] + accD[i][j]));
                    const float a = fast_sigmoid(a04[j] + accA[i][j]);
                    const float kraw = k * kk4[j], k2 = k * (1.f + (a - 1.f) * ka4[j]);
                    const float kkn = kraw * inv, bn = kkn * a; sbr += bn * r; skr += k2 * r; sbo += r * k2 * rk4[j];
                    okk[e8] = (h16)kkn; ob[e8] = (h16)bn;
                    owr[e8] = (h16)(dec * r); odec[e8] = (h16)dec; ok2[e8] = (h16)k2; ov[e8] = (h16)v;
                }
            }
            *(h16x8*)(scp + 0 * 64 + hf * 8) = okk; *(h16x8*)(scp + 3 * 64 + hf * 8) = ob; *(h16x8*)(scp + 1 * 64 + hf * 8) = owr; *(h16x8*)(scp + 2 * 64 + hf * 8) = odec; *(h16x8*)(scp + 4 * 64 + hf * 8) = ok2; *(h16x8*)(scp + 5 * 64 + hf * 8) = ov;
        }
        sbr += __shfl_xor(sbr, 16); sbr += __shfl_xor(sbr, 32); skr += __shfl_xor(skr, 16); skr += __shfl_xor(skr, 32); sbo += __shfl_xor(sbo, 16); sbo += __shfl_xor(sbo, 32);
        if (fq == 0) *(f32x4*)(SS + ((size_t)(b * 8 + h) * SEQ + tin) * 4) = (f32x4){sbr, skr, sbo, 0.f};
        }
        BAR_LDS();
        if (h < 7) { prep_w_store(lds, tid, wreg); BAR_LDS(); }
    }
    }
}
constexpr float QSCALE = 0.125f * 1.4426950408889634f;
__device__ __forceinline__ int frag_off(int f, int l) { return (f * 8 + (l >> 3)) * NPB + (l & 7) * 8; }
__device__ __forceinline__ void qk_norm_block(bf16_t* blk, int lane, const float* g, float mul) {
    const bf16_t* rowp = blk + (size_t)lane * NPB;
    u32x4 q[8]; float ss = 0.f;
#pragma unroll
    for (int i = 0; i < 8; ++i) { q[i] = *(const u32x4*)(rowp + i * 8);
        const float a0 = bflo(q[i].x), a1 = bfhi(q[i].x), a2 = bflo(q[i].y), a3 = bfhi(q[i].y), a4 = bflo(q[i].z), a5 = bfhi(q[i].z), a6 = bflo(q[i].w), a7 = bfhi(q[i].w);
        ss += (a0 * a0 + a1 * a1) + (a2 * a2 + a3 * a3) + (a4 * a4 + a5 * a5) + (a6 * a6 + a7 * a7); }
    const float sc = rsqrtf(ss * (1.f / 64.f) + 1e-6f) * mul;
    asm volatile("" ::: "memory");
#pragma unroll
    for (int i = 0; i < 8; ++i) { const f32x4 g0 = *(const f32x4*)(g + i * 8) * sc, g1 = *(const f32x4*)(g + i * 8 + 4) * sc; u32x4 w;
        w.x = pk2(bflo(q[i].x) * g0.x, bfhi(q[i].x) * g0.y); w.y = pk2(bflo(q[i].y) * g0.z, bfhi(q[i].y) * g0.w);
        w.z = pk2(bflo(q[i].z) * g1.x, bfhi(q[i].z) * g1.y); w.w = pk2(bflo(q[i].w) * g1.z, bfhi(q[i].w) * g1.w);
        *(u32x4*)(blk + frag_off((lane >> 5) * 4 + (i >> 1), (lane & 31) + 32 * (i & 1))) = w; }
}
__device__ __forceinline__ void prep_attn_item(const Params& p, LAS unsigned char* ldsw, int item, int lane) {
    bf16_t* PB = (bf16_t*)(p.ws + WS_PB);
    const int ch = item >> 3, h = item & 7;
    bf16_t* blk = PB + (size_t)(ch * 64) * NPB + h * 64;
    qk_norm_block(blk, lane, p.qn_g, QSCALE);
    qk_norm_block(blk + 512, lane, p.kn_g, 1.f);
    bf16_t* vblk = blk + 1024;
    LAS unsigned* tile = (LAS unsigned*)ldsw;
#pragma unroll
    for (int i = 0; i < 8; ++i) { const u32x4 v = *(const u32x4*)(vblk + (size_t)lane * NPB + i * 8);
        tile[lane * 33 + i * 4 + 0] = v.x; tile[lane * 33 + i * 4 + 1] = v.y; tile[lane * 33 + i * 4 + 2] = v.z; tile[lane * 33 + i * 4 + 3] = v.w; }
    LDS_WAIT();
    const LAS bf16_t* th = (const LAS bf16_t*)ldsw;
    unsigned w[32];
#pragma unroll
    for (int e = 0; e < 32; ++e) w[e] = (unsigned)th[(2 * e) * 66 + lane] | ((unsigned)th[(2 * e + 1) * 66 + lane] << 16);
#pragma unroll
    for (int s_ = 0; s_ < 4; ++s_)
#pragma unroll
        for (int hi = 0; hi < 2; ++hi)
            *(u32x4*)(vblk + frag_off((lane >> 5) * 4 + s_, (lane & 31) + 32 * hi)) = (u32x4){w[8 * s_ + 2 * hi], w[8 * s_ + 2 * hi + 1], w[8 * s_ + 4 + 2 * hi], w[8 * s_ + 4 + 2 * hi + 1]};
    LDS_WAIT();
}

constexpr int MS = 72;
__device__ __forceinline__ void mm64(const LAS bf16_t* Aop, const LAS bf16_t* Bop, f32x4 (&acc)[2], int wave, int fr, int fq) {
    const int a0 = 16 * (wave >> 1);
#pragma unroll
    for (int ks = 0; ks < 2; ++ks) {
        const bf16x8 bfr = *(const LAS bf16x8*)(Bop + (a0 + fr) * MS + ks * 32 + fq * 8);
#pragma unroll
        for (int nt = 0; nt < 2; ++nt) { const int b0 = 32 * (wave & 1) + 16 * nt;
            const bf16x8 afr = *(const LAS bf16x8*)(Aop + (b0 + fr) * MS + ks * 32 + fq * 8);
            acc[nt] = __builtin_amdgcn_mfma_f32_16x16x32_bf16(afr, bfr, acc[nt], 0, 0, 0); }
    }
}
__device__ __forceinline__ void st_bf4(LAS bf16_t* p, f32x4 v) { u32x2 w; w.x = pk2(v.x, v.y); w.y = pk2(v.z, v.w); *(LAS u32x2*)p = w; }
__device__ __forceinline__ h16* chunk_base(const Params& p, int item) { return (h16*)(p.ws + WS_SC) + ((size_t)(item >> 7) * SEQ + (size_t)(item & 127) * 64) * 384; }
__device__ __forceinline__ void chunk_load(const Params& p, int item, int tid, h16 (&raw)[48]) {
    const h16* base = chunk_base(p, item) + (size_t)(8 * (tid >> 6)) * 384 + (tid & 63);
#pragma unroll
    for (int i = 0; i < 8; ++i)
#pragma unroll
        for (int vq = 0; vq < 6; ++vq) raw[i * 6 + vq] = base[(size_t)i * 384 + vq * 64];
}
__device__ __forceinline__ void chunk_pre(const Params& p, LAS unsigned char* lds, int item, int next_item, int tid, int wave, int lane, h16 (&raw)[48]) {
    h16* base = chunk_base(p, item);
    LAS bf16_t* At = (LAS bf16_t*)lds; LAS bf16_t* Bt = At + 64 * MS; LAS bf16_t* Kt = Bt + 64 * MS; LAS bf16_t* Rt = Kt + 64 * MS;
    LAS bf16_t* BhT = Rt + 64 * MS; LAS bf16_t* KhT = BhT + 64 * MS; LAS bf16_t* VT = KhT + 64 * MS;
    LAS bf16_t* Mak = VT + 64 * MS; LAS bf16_t* Mrb = Mak + 64 * MS; LAS bf16_t* Mrk = Mrb + 64 * MS;
    LAS bf16_t* AbT = Bt; LAS bf16_t* P1T = Kt;
    LAS float* Mab = (LAS float*)(lds + 92160); LAS float* GT = (LAS float*)(lds + 141312);
    LAS bf16_t* AtT = (LAS bf16_t*)(lds + 108544); LAS bf16_t* RH2T = (LAS bf16_t*)(lds + 117760);
    LAS float* TD = (LAS float*)(lds + 126976); LAS float* Toff = (LAS float*)(lds + 131072); LAS float* Wf = (LAS float*)(lds + 137216);
    LAS bf16_t* Tb = At;
    const int fr = lane & 15, fq = lane >> 4;
    {
        const int g = tid >> 6, k = tid & 63;
        float wv[8], lp[8];
#pragma unroll
        for (int i = 0; i < 8; ++i) wv[i] = (float)raw[i * 6 + 2];
        lp[0] = wv[0];
#pragma unroll
        for (int i = 1; i < 8; ++i) lp[i] = lp[i - 1] * wv[i];
        GT[g * 64 + k] = lp[7];
        BAR_LDS();
        float bs = 1.f, WL = 1.f;
#pragma unroll
        for (int q = 0; q < 8; ++q) { const float gq = GT[q * 64 + k]; if (q < g) bs *= gq; WL *= gq; }
        float bhv[8], khv[8], vtv[8], atv[8];
#pragma unroll
        for (int i = 0; i < 8; ++i) {
            const int t = 8 * g + i;
            const float kk = (float)raw[i * 6 + 0], wr = (float)raw[i * 6 + 1], bb = (float)raw[i * 6 + 3], kx = (float)raw[i * 6 + 4], vv = (float)raw[i * 6 + 5];
            const float Wt = bs * lp[i], Wp = (i == 0) ? bs : bs * lp[i - 1], iW = 1.f / Wt;
            atv[i] = -kk * Wp; At[t * MS + k] = (bf16_t)(pk2(-kk * Wp, 0.f) & 0xffffu); Rt[t * MS + k] = (bf16_t)(pk2(wr * Wp, 0.f) & 0xffffu);
            Bt[t * MS + k] = (bf16_t)(pk2(bb * iW, 0.f) & 0xffffu); Kt[t * MS + k] = (bf16_t)(pk2(kx * iW, 0.f) & 0xffffu);
            bhv[i] = bb * iW * WL; khv[i] = kx * iW * WL; vtv[i] = vv;
        }
        *(LAS u32x4*)(BhT + k * MS + 8 * g) = (u32x4){pk2(bhv[0], bhv[1]), pk2(bhv[2], bhv[3]), pk2(bhv[4], bhv[5]), pk2(bhv[6], bhv[7])};
        *(LAS u32x4*)(KhT + k * MS + 8 * g) = (u32x4){pk2(khv[0], khv[1]), pk2(khv[2], khv[3]), pk2(khv[4], khv[5]), pk2(khv[6], khv[7])};
        *(LAS u32x4*)(VT + k * MS + 8 * g) = (u32x4){pk2(vtv[0], vtv[1]), pk2(vtv[2], vtv[3]), pk2(vtv[4], vtv[5]), pk2(vtv[6], vtv[7])};
        *(LAS u32x4*)(AtT + k * MS + 8 * g) = (u32x4){pk2(atv[0], atv[1]), pk2(atv[2], atv[3]), pk2(atv[4], atv[5]), pk2(atv[6], atv[7])};
    }
    if (next_item >= 0) chunk_load(p, next_item, tid, raw);
    BAR_LDS();
    const int a0 = 16 * (wave >> 1), ar = a0 + fr;
    {
        f32x4 acc[2];
#pragma unroll
        for (int which = 0; which < 4; ++which) {
            acc[0] = (f32x4){0.f, 0.f, 0.f, 0.f}; acc[1] = acc[0];
            mm64((which & 1) ? Kt : Bt, (which & 2) ? Rt : At, acc, wave, fr, fq);
#pragma unroll
            for (int nt = 0; nt < 2; ++nt) { const int s0 = 32 * (wave & 1) + 16 * nt + 4 * fq; f32x4 v = acc[nt];
#pragma unroll
                for (int jj = 0; jj < 4; ++jj) { const bool keep = (which & 2) ? (s0 + jj <= ar) : (s0 + jj < ar); if (!keep) v[jj] = 0.f; }
                if (which == 0) *(LAS f32x4*)(Mab + ar * 64 + s0) = v;
                else st_bf4(((which == 1) ? Mak : (which == 2) ? Mrb : Mrk) + ar * MS + s0, v); }
        }
    }
    BAR_LDS();
    {
        f32x4 acc[2]; acc[0] = (f32x4){0.f, 0.f, 0.f, 0.f}; acc[1] = acc[0];
        mm64(Mak, VT, acc, wave, fr, fq);
#pragma unroll
        for (int nt = 0; nt < 2; ++nt) st_bf4(RH2T + ar * MS + 32 * (wave & 1) + 16 * nt + 4 * fq, acc[nt]);
    }
    for (int e = tid; e < 6 * 256; e += 512) { const int ub = e >> 8, i = (e >> 4) & 15, j = e & 15;
        const int r = ub < 3 ? 0 : ub < 5 ? 1 : 2, c = ub < 3 ? ub + 1 : ub < 5 ? ub - 1 : 3; Tb[(16 * r + i) * MS + 16 * c + j] = 0; }
    if (tid < 64) {
        const int r = tid >> 4, j = tid & 15; float x[16];
#pragma unroll
        for (int i = 0; i < 16; ++i) x[i] = 0.f;
#pragma unroll
        for (int i = 0; i < 16; ++i) {
            const LAS float* mrow = Mab + (16 * r + i) * 64 + 16 * r;
            float v = (i == j) ? 1.f : 0.f;
#pragma unroll
            for (int q = 0; q < (i + 3) / 4; ++q) { const f32x4 m4 = *(const LAS f32x4*)(mrow + 4 * q);
                v += (m4.x * x[4 * q] + m4.y * x[4 * q + 1]) + (m4.z * x[4 * q + 2] + m4.w * x[4 * q + 3]); }
            x[i] = v; TD[r * 256 + i * 16 + j] = v; Tb[(16 * r + i) * MS + 16 * r + j] = (bf16_t)(pk2(v, 0.f) & 0xffffu);
        }
    }
    BAR_LDS();
#define M16(r_, q_, blkp) ({ const LAS float* mr_ = Mab + (16 * (r_) + i) * 64 + 16 * (q_); const LAS float* bp_ = (blkp) + j; float a_ = 0.f; \
        _Pragma("unroll") for (int u4 = 0; u4 < 4; ++u4) { const f32x4 m4 = *(const LAS f32x4*)(mr_ + 4 * u4); \
            a_ += (m4.x * bp_[(4 * u4) * 16] + m4.y * bp_[(4 * u4 + 1) * 16]) + (m4.z * bp_[(4 * u4 + 2) * 16] + m4.w * bp_[(4 * u4 + 3) * 16]); } a_; })
#define TDW(r_, wp) ({ const LAS float* tr_ = TD + (r_) * 256 + i * 16; const LAS float* bp_ = (wp) + j; float a_ = 0.f; \
        _Pragma("unroll") for (int u4 = 0; u4 < 4; ++u4) { const f32x4 t4 = *(const LAS f32x4*)(tr_ + 4 * u4); \
            a_ += (t4.x * bp_[(4 * u4) * 16] + t4.y * bp_[(4 * u4 + 1) * 16]) + (t4.z * bp_[(4 * u4 + 2) * 16] + t4.w * bp_[(4 * u4 + 3) * 16]); } a_; })
    for (int e = tid; e < 3 * 256; e += 512) { const int bk = e >> 8, i = (e >> 4) & 15, j = e & 15; Wf[bk * 256 + i * 16 + j] = M16(bk + 1, bk, TD + bk * 256); }
    BAR_LDS();
    for (int e = tid; e < 3 * 256; e += 512) { const int bk = e >> 8, i = (e >> 4) & 15, j = e & 15; const float t = TDW(bk + 1, Wf + bk * 256);
        Toff[bk * 256 + i * 16 + j] = t; Tb[(16 * (bk + 1) + i) * MS + 16 * bk + j] = (bf16_t)(pk2(t, 0.f) & 0xffffu); }
    BAR_LDS();
    { const int bk = tid >> 8, i = (tid >> 4) & 15, j = tid & 15; Wf[bk * 256 + i * 16 + j] = M16(bk + 2, bk, TD + bk * 256) + M16(bk + 2, bk + 1, Toff + bk * 256); }
    BAR_LDS();
    { const int bk = tid >> 8, i = (tid >> 4) & 15, j = tid & 15; const float t = TDW(bk + 2, Wf + bk * 256);
      Toff[(3 + bk) * 256 + i * 16 + j] = t; Tb[(16 * (bk + 2) + i) * MS + 16 * bk + j] = (bf16_t)(pk2(t, 0.f) & 0xffffu); }
    BAR_LDS();
    if (tid < 256) { const int i = tid >> 4, j = tid & 15; Wf[i * 16 + j] = M16(3, 0, TD) + M16(3, 1, Toff) + M16(3, 2, Toff + 3 * 256); }
    BAR_LDS();
    if (tid < 256) { const int i = tid >> 4, j = tid & 15; const float t = TDW(3, Wf); Tb[(48 + i) * MS + j] = (bf16_t)(pk2(t, 0.f) & 0xffffu); }
    BAR_LDS();
#undef M16
#undef TDW
    {
        f32x4 acc[2];
        acc[0] = (f32x4){0.f, 0.f, 0.f, 0.f}; acc[1] = acc[0]; mm64(Tb, AtT, acc, wave, fr, fq);
#pragma unroll
        for (int nt = 0; nt < 2; ++nt) st_bf4(AbT + ar * MS + 32 * (wave & 1) + 16 * nt + 4 * fq, acc[nt]);
        acc[0] = (f32x4){0.f, 0.f, 0.f, 0.f}; acc[1] = acc[0]; mm64(Tb, RH2T, acc, wave, fr, fq);
#pragma unroll
        for (int nt = 0; nt < 2; ++nt) st_bf4(P1T + ar * MS + 32 * (wave & 1) + 16 * nt + 4 * fq, acc[nt]);
    }
    BAR_LDS();
    {
        f32x4 acc[2];
        acc[0] = (f32x4){0.f, 0.f, 0.f, 0.f}; acc[1] = acc[0];
        mm64(AbT, Mrb, acc, wave, fr, fq);
#pragma unroll
        for (int nt = 0; nt < 2; ++nt) { const int b0 = 32 * (wave & 1) + 16 * nt + 4 * fq; const u32x2 rw = *(const LAS u32x2*)(Rt + ar * MS + b0);
            const f32x4 v = acc[nt] + (f32x4){bflo(rw.x), bfhi(rw.x), bflo(rw.y), bfhi(rw.y)};
            u32x2 w; w.x = pk2(v.x, v.y); w.y = pk2(v.z, v.w); *(u32x2*)(base + (size_t)(ar * 6 + 2) * 64 + b0) = w; }
        acc[0] = (f32x4){0.f, 0.f, 0.f, 0.f}; acc[1] = acc[0];
        mm64(P1T, Mrb, acc, wave, fr, fq); mm64(VT, Mrk, acc, wave, fr, fq);
#pragma unroll
        for (int nt = 0; nt < 2; ++nt) { const int b0 = 32 * (wave & 1) + 16 * nt + 4 * fq; *(f32x4*)((float*)(base + (size_t)(ar * 6 + 3) * 64) + b0) = acc[nt]; }
        acc[0] = (f32x4){0.f, 0.f, 0.f, 0.f}; acc[1] = acc[0];
        mm64(AbT, BhT, acc, wave, fr, fq);
        { float WL = 1.f;
#pragma unroll
          for (int q = 0; q < 8; ++q) WL *= GT[q * 64 + ar];
#pragma unroll
          for (int nt = 0; nt < 2; ++nt) { const int b0 = 32 * (wave & 1) + 16 * nt + 4 * fq; f32x4 v = acc[nt];
#pragma unroll
              for (int jj = 0; jj < 4; ++jj) if (b0 + jj == ar) v[jj] += WL;
              u32x2 w; w.x = pk2(v.x, v.y); w.y = pk2(v.z, v.w); *(u32x2*)(base + (size_t)(ar * 6 + 0) * 64 + b0) = w; } }
        acc[0] = (f32x4){0.f, 0.f, 0.f, 0.f}; acc[1] = acc[0];
        mm64(BhT, P1T, acc, wave, fr, fq); mm64(KhT, VT, acc, wave, fr, fq);
#pragma unroll
        for (int nt = 0; nt < 2; ++nt) { const int b0 = 32 * (wave & 1) + 16 * nt + 4 * fq; const f32x4 v = acc[nt];
            u32x2 w; w.x = pk2(v.x, v.y); w.y = pk2(v.z, v.w); *(u32x2*)(base + (size_t)(ar * 6 + 1) * 64 + b0) = w; }
    }
    BAR_LDS();
}
constexpr int CHAIN_LDS = 16640;
__device__ __forceinline__ void chain_head(const Params& p, LAS unsigned char* lds, int bh, int wave, int lane) {
    const int fr = lane & 15, fq = lane >> 4, a0 = 16 * (wave >> 1), ar = a0 + fr, bw = 32 * (wave & 1);
    LAS bf16_t* Sb = (LAS bf16_t*)(lds + CHAIN_LDS);
    LAS bf16_t* Pb = Sb + 2 * 64 * MS;
    LAS bf16_t* Zb = Pb + 2 * 64 * MS;
    h16* hb = (h16*)(p.ws + WS_SC) + (size_t)bh * SEQ * 384;
    for (int i = wave * 64 + lane; i < 2 * 64 * MS / 2; i += 512) ((LAS unsigned*)Sb)[i] = 0u;
    const int prow = 8 * wave + (lane >> 3), ppc = (lane & 7) * 8;
    u32x4 phA, phB, phC, phD, phE, phF, phG, phH, zzA, zzB, zzC, zzD, zzE, zzF, zzG, zzH;
#define CH_LOAD(X, cc_) do { const h16* base = hb + (size_t)(cc_) * 64 * 384; \
        ph##X = *(const u32x4*)(base + (size_t)(prow * 6 + 0) * 64 + ppc); zz##X = *(const u32x4*)(base + (size_t)(prow * 6 + 1) * 64 + ppc); } while (0)
#define CH_STEP(X, XN, cc_) do { const int c_ = (cc_); const LAS bf16_t* Sc = Sb + (c_ & 1) * (64 * MS); LAS bf16_t* Sn = Sb + ((c_ & 1) ^ 1) * (64 * MS); \
        const LAS bf16_t* Pc = Pb + (c_ & 1) * (64 * MS); LAS bf16_t* Pn = Pb + ((c_ & 1) ^ 1) * (64 * MS); \
        const LAS bf16_t* Zc = Zb + (c_ & 1) * (64 * MS); LAS bf16_t* Zn = Zb + ((c_ & 1) ^ 1) * (64 * MS); \
        h16* base = hb + (size_t)c_ * 64 * 384; f32x4 accs[2]; \
        *(u32x4*)(base + (size_t)(prow * 6 + 1) * 64 + ppc) = *(const LAS u32x4*)(Sc + prow * MS + ppc); \
        _Pragma("unroll") for (int nt = 0; nt < 2; ++nt) { const u32x2 z_ = *(const LAS u32x2*)(Zc + ar * MS + bw + 16 * nt + 4 * fq); accs[nt] = (f32x4){bflo(z_.x), bfhi(z_.x), bflo(z_.y), bfhi(z_.y)}; } \
        if (c_ + 1 < SEQ / 64) { *(LAS u32x4*)(Pn + prow * MS + ppc) = ph##XN; *(LAS u32x4*)(Zn + prow * MS + ppc) = zz##XN; } \
        if (c_ + 8 < SEQ / 64) CH_LOAD(X, c_ + 8); \
        _Pragma("unroll") for (int ks = 0; ks < 2; ++ks) { const bf16x8 sv = *(const LAS bf16x8*)(Sc + ar * MS + ks * 32 + fq * 8); \
            _Pragma("unroll") for (int nt = 0; nt < 2; ++nt) { const bf16x8 pf_ = *(const LAS bf16x8*)(Pc + (bw + 16 * nt + fr) * MS + ks * 32 + fq * 8); \
                accs[nt] = __builtin_amdgcn_mfma_f32_16x16x32_bf16(pf_, sv, accs[nt], 0, 0, 0); } } \
        _Pragma("unroll") for (int nt = 0; nt < 2; ++nt) st_bf4(Sn + ar * MS + bw + 16 * nt + 4 * fq, accs[nt]); \
        BAR_LDS(); } while (0)
    CH_LOAD(A, 0); CH_LOAD(B, 1); CH_LOAD(C, 2); CH_LOAD(D, 3); CH_LOAD(E, 4); CH_LOAD(F, 5); CH_LOAD(G, 6); CH_LOAD(H, 7);
    *(LAS u32x4*)(Pb + prow * MS + ppc) = phA; *(LAS u32x4*)(Zb + prow * MS + ppc) = zzA;
    BAR_LDS();
#pragma unroll
    for (int c = 0; c < SEQ / 64; c += 8) { CH_STEP(A, B, c); CH_STEP(B, C, c + 1); CH_STEP(C, D, c + 2); CH_STEP(D, E, c + 3); CH_STEP(E, F, c + 4); CH_STEP(F, G, c + 5); CH_STEP(G, H, c + 6); CH_STEP(H, A, c + 7); }
#undef CH_LOAD
#undef CH_STEP
}
__device__ __forceinline__ void rwkv_out_ch(const Params& p, LAS unsigned char* ldsw, int ch, int lane) {
    const int bh = ch >> 7, c = ch & 127, b = bh >> 3, h = bh & 7, fr = lane & 15, fq = lane >> 4;
    const h16* base = (const h16*)(p.ws + WS_SC) + ((size_t)bh * SEQ + (size_t)c * 64) * 384;
    const bf16_t* G = (const bf16_t*)(p.ws + WS_G); const float* SS = (const float*)(p.ws + WS_SS); bf16_t* MIX = (bf16_t*)(p.ws + WS_MIX);
    LAS bf16_t* stg = (LAS bf16_t*)ldsw;
    bf16x8 sf[4][2]; f32x4 lg[4], lb[4];
#pragma unroll
    for (int nt = 0; nt < 4; ++nt) {
#pragma unroll
        for (int ks = 0; ks < 2; ++ks) sf[nt][ks] = *(const bf16x8*)(base + (size_t)((16 * nt + fr) * 6 + 1) * 64 + ks * 32 + fq * 8);
        const int cc = h * 64 + 16 * fq + 4 * nt; lg[nt] = *(const f32x4*)(p.lnx_g + cc); lb[nt] = *(const f32x4*)(p.lnx_b + cc);
    }
#pragma unroll 1
    for (int ts = 0; ts < 4; ++ts) {
        const int t = 16 * ts + fr, tin = c * 64 + t; const size_t m = (size_t)b * SEQ + tin;
        bf16x8 rbf[2]; f32x4 acc[4];
#pragma unroll
        for (int ks = 0; ks < 2; ++ks) rbf[ks] = *(const bf16x8*)(base + (size_t)(t * 6 + 2) * 64 + ks * 32 + fq * 8);
#pragma unroll
        for (int nt = 0; nt < 4; ++nt) acc[nt] = *(const f32x4*)((const float*)(base + (size_t)(t * 6 + 3) * 64) + 16 * nt + 4 * fq);
        u32x2 gw2[4]; h16x4 v4[4];
#pragma unroll
        for (int nt = 0; nt < 4; ++nt) { const int v0 = 16 * nt + 4 * fq; gw2[nt] = *(const u32x2*)(G + m * 512 + h * 64 + v0); v4[nt] = *(const h16x4*)(base + (size_t)(t * 6 + 5) * 64 + v0); }
        const float bon = SS[((size_t)bh * SEQ + tin) * 4 + 2];
#pragma unroll
        for (int nt = 0; nt < 4; ++nt)
#pragma unroll
            for (int ks = 0; ks < 2; ++ks) acc[nt] = __builtin_amdgcn_mfma_f32_16x16x32_bf16(sf[nt][ks], rbf[ks], acc[nt], 0, 0, 0);
        float s_ = 0.f;
#pragma unroll
        for (int nt = 0; nt < 4; ++nt) s_ += (acc[nt].x + acc[nt].y) + (acc[nt].z + acc[nt].w);
        s_ += __shfl_xor(s_, 16); s_ += __shfl_xor(s_, 32);
        const float mean = s_ * (1.f / 64.f); float q = 0.f;
#pragma unroll
        for (int nt = 0; nt < 4; ++nt) { acc[nt] = acc[nt] - mean; q += (acc[nt].x * acc[nt].x + acc[nt].y * acc[nt].y) + (acc[nt].z * acc[nt].z + acc[nt].w * acc[nt].w); }
        q += __shfl_xor(q, 16); q += __shfl_xor(q, 32);
        const float rstd = rsqrtf(q * (1.f / 64.f) + 64e-5f);
#pragma unroll
        for (int nt = 0; nt < 4; ++nt) {
            const f32x4 g = {bflo(gw2[nt].x), bfhi(gw2[nt].x), bflo(gw2[nt].y), bfhi(gw2[nt].y)}, vv = {(float)v4[nt][0], (float)v4[nt][1], (float)v4[nt][2], (float)v4[nt][3]};
            st_bf4(stg + fr * MS + 16 * fq + 4 * nt, (acc[nt] * rstd * lg[nt] + lb[nt] + vv * bon) * g);
        }
        LDS_WAIT();
        {
            const int row = lane >> 2, pc = (lane & 3) * 16;
            const u32x4 w0 = *(const LAS u32x4*)(stg + row * MS + pc), w1 = *(const LAS u32x4*)(stg + row * MS + pc + 8);
            bf16_t* dst = MIX + ((size_t)b * SEQ + c * 64 + 16 * ts + row) * DM + h * 64 + pc;
            *(u32x4*)dst = w0; *(u32x4*)(dst + 8) = w1;
        }
        LDS_WAIT();
    }
}
__device__ __forceinline__ void rwkv_out_item(const Params& p, int item, int lane) {
    const int ts = item & 3, ch = item >> 2, bh = ch >> 7, c = ch & 127, b = bh >> 3, h = bh & 7, fr = lane & 15, fq = lane >> 4;
    const h16* base = (const h16*)(p.ws + WS_SC) + ((size_t)bh * SEQ + (size_t)c * 64) * 384;
    const int t = 16 * ts + fr, tin = c * 64 + t; const size_t m = (size_t)b * SEQ + tin;
    const bf16_t* G = (const bf16_t*)(p.ws + WS_G); const float* SS = (const float*)(p.ws + WS_SS); bf16_t* MIX = (bf16_t*)(p.ws + WS_MIX);
    bf16x8 rbf[2]; f32x4 acc[4];
#pragma unroll
    for (int ks = 0; ks < 2; ++ks) rbf[ks] = *(const bf16x8*)(base + (size_t)(t * 6 + 2) * 64 + ks * 32 + fq * 8);
#pragma unroll
    for (int nt = 0; nt < 4; ++nt) acc[nt] = *(const f32x4*)((const float*)(base + (size_t)(t * 6 + 3) * 64) + 16 * nt + 4 * fq);
#pragma unroll
    for (int nt = 0; nt < 4; ++nt)
#pragma unroll
        for (int ks = 0; ks < 2; ++ks) { const bf16x8 sf = *(const bf16x8*)(base + (size_t)((16 * nt + fr) * 6 + 1) * 64 + ks * 32 + fq * 8);
            acc[nt] = __builtin_amdgcn_mfma_f32_16x16x32_bf16(sf, rbf[ks], acc[nt], 0, 0, 0); }
    float s = 0.f;
#pragma unroll
    for (int nt = 0; nt < 4; ++nt) s += (acc[nt].x + acc[nt].y) + (acc[nt].z + acc[nt].w);
    s += __shfl_xor(s, 16); s += __shfl_xor(s, 32);
    const float mean = s * (1.f / 64.f); float q = 0.f;
#pragma unroll
    for (int nt = 0; nt < 4; ++nt) { acc[nt] = acc[nt] - mean; q += (acc[nt].x * acc[nt].x + acc[nt].y * acc[nt].y) + (acc[nt].z * acc[nt].z + acc[nt].w * acc[nt].w); }
    q += __shfl_xor(q, 16); q += __shfl_xor(q, 32);
    const float rstd = rsqrtf(q * (1.f / 64.f) + 64e-5f);
    const float bon = SS[((size_t)bh * SEQ + tin) * 4 + 2];
#pragma unroll
    for (int nt = 0; nt < 4; ++nt) { const int v0 = 16 * nt + 4 * fq  , cc = h * 64 + 16 * fq + 4 * nt  ;
        const f32x4 lg = *(const f32x4*)(p.lnx_g + cc), lb = *(const f32x4*)(p.lnx_b + cc);
        const u32x2 gw2 = *(const u32x2*)(G + m * 512 + h * 64 + v0); const h16x4 v4 = *(const h16x4*)(base + (size_t)(t * 6 + 5) * 64 + v0);
        const f32x4 g = {bflo(gw2.x), bfhi(gw2.x), bflo(gw2.y), bfhi(gw2.y)}, vv = {(float)v4[0], (float)v4[1], (float)v4[2], (float)v4[3]};
        const f32x4 o = (acc[nt] * rstd * lg + lb + vv * bon) * g;
        u32x2 w; w.x = pk2(o.x, o.y); w.y = pk2(o.z, o.w); *(u32x2*)(MIX + m * DM + cc) = w; }
}

__device__ __forceinline__ int crow(int r, int hi) { return (r & 3) + 8 * (r >> 2) + 4 * hi; }
__device__ __forceinline__ void attn_unit(const Params& p, const LAS float* bl, LAS bf16_t* stg, int unit, int lane) {
    const bf16_t* PB = (const bf16_t*)(p.ws + WS_PB); bf16_t* MIX = (bf16_t*)(p.ws + WS_MIX);
    const int half = unit & 1, cq = (unit >> 1) & 127, bh = unit >> 8, b = bh >> 3, h = bh & 7;
    const int r32 = lane & 31, hi = lane >> 5;
    const unsigned loff = (unsigned)(((lane >> 3) * NPB + (lane & 7) * 8) * 2);
#define FRAGP(blk, f) ((const u32x4*)((const char*)(blk) + (size_t)(f) * (8 * NPB * 2) + loff))
    const size_t tok0 = (size_t)b * SEQ;
    const bf16_t* qblk = PB + (tok0 + cq * 64) * NPB + h * 64;
    bf16x8 qf[4];
#pragma unroll
    for (int d0 = 0; d0 < 4; ++d0) qf[d0] = __builtin_bit_cast(bf16x8, *FRAGP(qblk, half * 4 + d0));
    f32x16 o0 = {}, o1 = {}; float lsum = 0.f;
    const LAS float* blh = bl + h * 513;
    const int qi = half * 32 + r32;
    u32x4 kc[8], vc[8];
    const int dl0 = (cq < 8 ? cq : 8);
    { const bf16_t* kblk = PB + (tok0 + (size_t)(cq - dl0) * 64) * NPB + 512 + h * 64;
#pragma unroll
      for (int f = 0; f < 8; ++f) kc[f] = *FRAGP(kblk, f); }
    for (int dlt = dl0; dlt >= 0; --dlt) {
        const size_t krow0 = tok0 + (size_t)(cq - dlt) * 64;
        { const bf16_t* vblk = PB + krow0 * NPB + 1024 + h * 64;
#pragma unroll
          for (int f = 0; f < 8; ++f) vc[f] = *FRAGP(vblk, f); }
        __builtin_amdgcn_sched_barrier(0);
        f32x16 s0, s1;
        if (dlt >= 5) {
            const float bc = blh[512];
#pragma unroll
            for (int r = 0; r < 16; ++r) { s0[r] = bc; s1[r] = bc; }
        } else if (dlt == 4) {
            const int base = dlt * 64 + qi + 256;
#pragma unroll
            for (int r = 0; r < 16; ++r) { const int kv = crow(r, hi); int i0 = base - kv, i1 = base - kv - 32; i0 = i0 > 512 ? 512 : i0; i1 = i1 > 512 ? 512 : i1; s0[r] = blh[i0]; s1[r] = blh[i1]; }
        } else {
            const LAS float* bp = blh + (dlt * 64 + qi + 256 - 4 * hi - 59);
#pragma unroll
            for (int r = 0; r < 16; ++r) { const int k0 = (r & 3) + 8 * (r >> 2); s0[r] = bp[59 - k0]; s1[r] = bp[27 - k0]; }
        }
#pragma unroll
        for (int d0 = 0; d0 < 4; ++d0) {
            s0 = __builtin_amdgcn_mfma_f32_32x32x16_bf16(__builtin_bit_cast(bf16x8, kc[d0]), qf[d0], s0, 0, 0, 0);
            s1 = __builtin_amdgcn_mfma_f32_32x32x16_bf16(__builtin_bit_cast(bf16x8, kc[4 + d0]), qf[d0], s1, 0, 0, 0);
        }
        if (dlt > 0) { const bf16_t* kblk = PB + (krow0 + 64) * NPB + 512 + h * 64;
#pragma unroll
          for (int f = 0; f < 8; ++f) kc[f] = *FRAGP(kblk, f); }
        __builtin_amdgcn_sched_barrier(0);
#pragma unroll
        for (int r = 0; r < 16; ++r) { s0[r] = __builtin_amdgcn_exp2f(s0[r]); s1[r] = __builtin_amdgcn_exp2f(s1[r]); }
        float ls = 0.f;
#pragma unroll
        for (int r = 0; r < 16; ++r) ls += s0[r] + s1[r];
        lsum += ls;
        u32x4 pf[4];
        pf[0] = (u32x4){pk2(s0[0], s0[1]), pk2(s0[2], s0[3]), pk2(s0[4], s0[5]), pk2(s0[6], s0[7])};
        pf[1] = (u32x4){pk2(s0[8], s0[9]), pk2(s0[10], s0[11]), pk2(s0[12], s0[13]), pk2(s0[14], s0[15])};
        pf[2] = (u32x4){pk2(s1[0], s1[1]), pk2(s1[2], s1[3]), pk2(s1[4], s1[5]), pk2(s1[6], s1[7])};
        pf[3] = (u32x4){pk2(s1[8], s1[9]), pk2(s1[10], s1[11]), pk2(s1[12], s1[13]), pk2(s1[14], s1[15])};
#pragma unroll
        for (int s = 0; s < 4; ++s) {
            o0 = __builtin_amdgcn_mfma_f32_32x32x16_bf16(__builtin_bit_cast(bf16x8, vc[s]), __builtin_bit_cast(bf16x8, pf[s]), o0, 0, 0, 0);
            o1 = __builtin_amdgcn_mfma_f32_32x32x16_bf16(__builtin_bit_cast(bf16x8, vc[4 + s]), __builtin_bit_cast(bf16x8, pf[s]), o1, 0, 0, 0);
        }
    }
    lsum += __shfl_xor(lsum, 32);
    const float il = 1.f / lsum;
#pragma unroll
    for (int g = 0; g < 4; ++g) {
        st_bf4(stg + r32 * MS + 8 * g + 4 * hi, (f32x4){o0[4 * g] * il, o0[4 * g + 1] * il, o0[4 * g + 2] * il, o0[4 * g + 3] * il});
        st_bf4(stg + r32 * MS + 32 + 8 * g + 4 * hi, (f32x4){o1[4 * g] * il, o1[4 * g + 1] * il, o1[4 * g + 2] * il, o1[4 * g + 3] * il});
    }
    LDS_WAIT();
#pragma unroll
    for (int i = 0; i < 4; ++i) { const int row = 8 * i + (lane >> 3), pc = (lane & 7) * 8;
        *(u32x4*)(MIX + (tok0 + cq * 64 + half * 32 + row) * DM + 512 + h * 64 + pc) = *(const LAS u32x4*)(stg + row * MS + pc); }
    LDS_WAIT();
}
#undef FRAGP
__device__ __forceinline__ void finalize_phase(const Params& p, int gw, int ngw, int lane) {
    const bf16_t* Y = (const bf16_t*)(p.ws + WS_Y); const bf16_t* G = (const bf16_t*)(p.ws + WS_G);
    const h16* SC = (const h16*)(p.ws + WS_SC); const float* SS = (const float*)(p.ws + WS_SS); bf16_t* MIX = (bf16_t*)(p.ws + WS_MIX);
    for (int it = gw; it < MTOK * 2; it += ngw) {
        const int m = it >> 1, h = (it & 1) * 4 + (lane >> 4), cc = (lane & 15) * 4, c = h * 64 + cc, b = m >> 13, tin = m & 8191;
        const u32x2 yw = *(const u32x2*)(Y + (size_t)m * 512 + c), gw2 = *(const u32x2*)(G + (size_t)m * 512 + c);
        const h16x4 v4 = *(const h16x4*)(SC + ((size_t)(b * 8 + h) * SEQ + tin) * 384 + 5 * 64 + cc);
        const float bon = SS[((size_t)(b * 8 + h) * SEQ + tin) * 4 + 2];
        const f32x4 lg = *(const f32x4*)(p.lnx_g + c), lb = *(const f32x4*)(p.lnx_b + c);
        const f32x4 y = {bflo(yw.x), bfhi(yw.x), bflo(yw.y), bfhi(yw.y)}, g = {bflo(gw2.x), bfhi(gw2.x), bflo(gw2.y), bfhi(gw2.y)};
        float s = (y.x + y.y) + (y.z + y.w); s = row16_sum(s);
        const float mean = s * (1.f / 64.f); const f32x4 d = y - mean;
        float q = (d.x * d.x + d.y * d.y) + (d.z * d.z + d.w * d.w); q = row16_sum(q);
        const float rstd = rsqrtf(q * (1.f / 64.f) + 64e-5f);
        const f32x4 vv = {(float)v4[0], (float)v4[1], (float)v4[2], (float)v4[3]};
        const f32x4 o = (d * rstd * lg + lb + vv * bon) * g;
        u32x2 w; w.x = pk2(o.x, o.y); w.y = pk2(o.z, o.w);
        *(u32x2*)(MIX + (size_t)m * DM + c) = w;
    }
}

#define XB_TMO      128
#define XB_XCNT(j)  (256  + 64 * (j))
#define XB_XSUB(j)  (1280 + 64 * (j))
#define XB_XGEN(j)  (2304 + 64 * (j))
#define XB_TOP      3328
#define XB_TOPGEN   3392
#define XCD_BAR_WORDS 3456
#define XB_SPIN_CAP (1u << 18)

__device__ __forceinline__ unsigned xb_ld(unsigned* p)              { return __hip_atomic_load(p, __ATOMIC_RELAXED, __HIP_MEMORY_SCOPE_AGENT); }
__device__ __forceinline__ unsigned xb_add(unsigned* p, unsigned v) { return __hip_atomic_fetch_add(p, v, __ATOMIC_RELAXED, __HIP_MEMORY_SCOPE_AGENT); }
__device__ __forceinline__ unsigned xb_xcc_id() { return (unsigned)__builtin_amdgcn_s_getreg((3 << 11) | 20) & 0xFu; }
#define XB_SPIN(cond, bar) do { unsigned _sp = 0; while (cond) { __builtin_amdgcn_s_sleep(1); \
    if ((++_sp & 255u) == 0u) { if (xb_ld(&(bar)[XB_TMO])) break; if (_sp > XB_SPIN_CAP) { atomicAdd(&(bar)[XB_TMO], 1u); break; } } } } while (0)

struct XcdBarrier {
    unsigned w0;
    unsigned* bar; unsigned x;
    volatile LAS unsigned* st;
};

__device__ __forceinline__ XcdBarrier xcd_barrier_post(unsigned* bar, volatile LAS unsigned* st, unsigned w0) {
    XcdBarrier b; b.w0 = w0; b.bar = bar; b.x = xb_xcc_id(); b.st = st;
    if (w0 && lane_now() == 0) (void)xb_add(&bar[XB_XCNT(b.x)], 1u);
    return b;
}
__device__ __forceinline__ void xcd_barrier_complete(unsigned* bar, unsigned x, unsigned& nloc, unsigned& nx) {
    const unsigned G = gridDim.x * gridDim.y * gridDim.z;
    unsigned sum, cnt, mine, sp = 0u;
    for (;;) {
        sum = 0u; cnt = 0u; mine = 0u;
#pragma unroll
        for (unsigned j = 0; j < 16; ++j) { const unsigned c = xb_ld(&bar[XB_XCNT(j)]); sum += c; cnt += (c > 0u) ? 1u : 0u; mine = (j == x) ? c : mine; }
        if (sum == G) break;
        __builtin_amdgcn_s_sleep(1);
        if ((++sp & 255u) == 0u) { if (xb_ld(&bar[XB_TMO])) break; if (sp > XB_SPIN_CAP) { atomicAdd(&bar[XB_TMO], 1u); break; } }
    }
    nloc = mine > 0u ? mine : 1u; nx = cnt > 0u ? cnt : 1u;
}

__device__ __forceinline__ void xcd_barrier(const XcdBarrier& b) {
    asm volatile("s_waitcnt vmcnt(0)" ::: "memory");
    __syncthreads();
    if (b.w0 && lane_now() == 0) {
        unsigned* bar = b.bar;
        __builtin_amdgcn_s_waitcnt(0);
        unsigned nloc = b.st[0], nx = b.st[1];
        if (nloc == 0u) { xcd_barrier_complete(bar, b.x, nloc, nx); b.st[0] = nloc; b.st[1] = nx; }
        const unsigned old = xb_add(&bar[XB_XSUB(b.x)], 1u);
        const unsigned gen = old / nloc;
        if (old + 1u == (gen + 1u) * nloc) {
            __builtin_amdgcn_fence(__ATOMIC_RELEASE, "agent");
            asm volatile("s_waitcnt vmcnt(0)" ::: "memory");
            const unsigned og = xb_add(&bar[XB_TOP], 1u);
            const unsigned tg = og / nx;
            if (og + 1u == (tg + 1u) * nx) xb_add(&bar[XB_TOPGEN], 1u);
            else XB_SPIN(xb_ld(&bar[XB_TOPGEN]) == tg, bar);
            __builtin_amdgcn_fence(__ATOMIC_ACQUIRE, "agent");
            xb_add(&bar[XB_XGEN(b.x)], 1u);
            asm volatile("s_waitcnt vmcnt(0)" ::: "memory");
        } else {
            XB_SPIN(xb_ld(&bar[XB_XGEN(b.x)]) == gen, bar);
            __builtin_amdgcn_fence(__ATOMIC_ACQUIRE, "agent");
            asm volatile("s_waitcnt vmcnt(0)" ::: "memory");
        }
    }
    __syncthreads();
}

__global__ void __launch_bounds__(512, 2) mega_fwd(Params p) {
    extern __shared__ __attribute__((aligned(16))) unsigned char lds_raw[];
    cg::grid_group grid = cg::this_grid();
    LAS unsigned char* lds = (LAS unsigned char*)lds_raw;
    const int wave = __builtin_amdgcn_readfirstlane((int)threadIdx.x >> 6);
#define lane (lane_now())
#define tid (wave * 64 + lane_now())
    const int G = gridDim.x, gw = blockIdx.x * 8 + wave, ngw = G * 8;
    unsigned char* ws = p.ws;
    float* mod = (float*)(ws + WS_MOD);
    bf16_t* XN = (bf16_t*)(ws + WS_XN); bf16_t* HID = (bf16_t*)(ws + WS_HID); bf16_t* MIX = (bf16_t*)(ws + WS_MIX);

    { const int t0_ = tid; if (t0_ < 2) *(LAS unsigned*)(lds + LDS_BYTES - 64 + 4 * t0_) = 0u; }
    __syncthreads();
    const XcdBarrier xbar = xcd_barrier_post((unsigned*)(ws + WS_BAR), (volatile LAS unsigned*)(lds + LDS_BYTES - 64), wave == 0 ? 1u : 0u);
    { const int l0_ = lane; p0_convert(p, lds, gw, ngw, wave, l0_); p0_mod(p, lds, wave * 64 + l0_, wave, l0_); }
    grid.sync();
    norm_phase(p.x, p.norm1_g, mod, 0, 1, XN, lds, gw, ngw, wave, lane);
    xcd_barrier(xbar);
    { pg8::Gemm g{XN, (const bf16_t*)(ws + WS_W13_1), MTOK, 2 * DFF, DM}; pg8::StaticOrder S; S.init(MTOK, 2 * DFF, G, (int)blockIdx.x);
      EpiSwiGLU E{HID, DFF}; pg8::gemm_phase<EpiSwiGLU, pg8::StaticOrder, true, true>(lds, g, S, E, wave); }
    xcd_barrier(xbar);
    { pg8::Gemm g{HID, (const bf16_t*)(ws + WS_W2_1), MTOK, DM, DFF}; pg8::StaticOrder S; S.init(MTOK, DM, G, (int)blockIdx.x);
      EpiResid E{p.x, p.out, mod + 2 * 1024, 0.5f}; pg8::gemm_phase<EpiResid, pg8::StaticOrder, true, true>(lds, g, S, E, wave); }
    xcd_barrier(xbar);
    norm_phase(p.out, p.norm2_g, mod, 3, 4, XN, lds, gw, ngw, wave, lane);
    xcd_barrier(xbar);
    { pg8::Gemm g{XN, (const bf16_t*)(ws + WS_WIN), MTOK, NIN, DM}; pg8::StaticOrder S; S.init(MTOK, NIN, G, (int)blockIdx.x);
      EpiProj E{(bf16_t*)(ws + WS_PA), (bf16_t*)(ws + WS_PB)}; pg8::gemm_phase<EpiProj, pg8::StaticOrder, true, true>(lds, g, S, E, wave); }
    xcd_barrier(xbar);
    { const int lane6 = lane; LAS unsigned char* ldsw = lds + wave * 8448;
      prep_rwkv_phase(p, lds, gw, ngw, wave, lane6);
      BAR_LDS();
      for (int it = gw; it < (MTOK / 64) * 8; it += ngw) prep_attn_item(p, ldsw, it, lane6); }
    xcd_barrier(xbar);
    { const int lane7 = lane, tid7 = wave * 64 + lane7;
      h16 raw[48]; if ((int)blockIdx.x < 32 * 128) chunk_load(p, (int)blockIdx.x, tid7, raw);
      for (int it = blockIdx.x; it < 32 * 128; it += G) chunk_pre(p, lds, it, (it + G < 32 * 128) ? it + G : -1, tid7, wave, lane7, raw); }
    xcd_barrier(xbar);
    {
        LAS float* bl = (LAS float*)lds; const int lane8 = lane;
        {
            float gq = 0.f, gk = 0.f;
            for (int i = 0; i < 64; ++i) { gq = fmaxf(gq, fabsf(p.qn_g[i])); gk = fmaxf(gk, fabsf(p.kn_g[i])); }
            const float mb = 8.f * gq * gk * 1.4426950408889634f;
            for (int i = wave * 64 + lane8; i < 8 * 513; i += 512) bl[i] = p.rel_bias[i] * 1.4426950408889634f - mb;
        }
        __syncthreads();
        for (int bh = blockIdx.x; bh < 32; bh += G) chain_head(p, lds, bh, wave, lane8);
        const int lane8a = lane;
        unsigned* qbase = (unsigned*)(ws + WS_QCTR);
        const unsigned myx = xbar.x & 7u;
        for (unsigned qi = 0; qi < 8u; ++qi) {
            const unsigned qx = (myx + qi) & 7u; unsigned* qctr = qbase + 64 * qx;
            for (;;) {
                unsigned u = 0u;
                if (lane8a == 0) u = __hip_atomic_fetch_add(qctr, 1u, __ATOMIC_RELAXED, __HIP_MEMORY_SCOPE_AGENT);
                u = (unsigned)__builtin_amdgcn_readfirstlane((int)u);
                if (u >= 4u * 256u) break;
                attn_unit(p, bl, (LAS bf16_t*)(lds + 73728 + wave * (32 * MS * 2)), (int)(((qx + 8u * (u >> 8)) << 8) | (u & 255u)), lane8a);
            }
        }
    }
    xcd_barrier(xbar);
    { const int lane9 = lane; LAS unsigned char* ldsw = lds + wave * (16 * MS * 2); for (int it = gw; it < 32 * 128; it += ngw) rwkv_out_ch(p, ldsw, it, lane9); }
    xcd_barrier(xbar);
    { pg8::Gemm g{MIX, (const bf16_t*)(ws + WS_WOUT), MTOK, DM, DM}; pg8::StaticOrder S; S.init(MTOK, DM, G, (int)blockIdx.x);
      EpiResid E{p.out, p.out, mod + 5 * 1024, 1.0f}; pg8::gemm_phase<EpiResid, pg8::StaticOrder, true, true>(lds, g, S, E, wave); }
    xcd_barrier(xbar);
    norm_phase(p.out, p.norm3_g, mod, 6, 7, XN, lds, gw, ngw, wave, lane);
    xcd_barrier(xbar);
    { pg8::Gemm g{XN, (const bf16_t*)(ws + WS_W13_2), MTOK, 2 * DFF, DM}; pg8::StaticOrder S; S.init(MTOK, 2 * DFF, G, (int)blockIdx.x);
      EpiSwiGLU E{HID, DFF}; pg8::gemm_phase<EpiSwiGLU, pg8::StaticOrder, true, true>(lds, g, S, E, wave); }
    xcd_barrier(xbar);
    { pg8::Gemm g{HID, (const bf16_t*)(ws + WS_W2_2), MTOK, DM, DFF}; pg8::StaticOrder S; S.init(MTOK, DM, G, (int)blockIdx.x);
      EpiResid E{p.out, p.out, mod + 8 * 1024, 0.5f}; pg8::gemm_phase<EpiResid, pg8::StaticOrder, true, true>(lds, g, S, E, wave); }
}

#undef lane
#undef tid
extern "C" void kernel_launch(void* const* d_in, const int* in_sizes, int n_in, void* d_out, int out_size, void* d_ws, size_t ws_size, hipStream_t stream) {
    static int grid = 0;
    if (grid == 0) {
        if (n_in != 29 || in_sizes[0] != MTOK * DM || out_size != MTOK * DM || ws_size < WS_END) {
            fprintf(stderr, "kernel_launch: unexpected shapes/workspace (n_in %d, in0 %d, out %d, ws %zu)\n", n_in, n_in > 0 ? in_sizes[0] : -1, out_size, ws_size); grid = -1; return; }
        int dev = 0, cus = 0, per_cu = 0;
        hipGetDevice(&dev); hipDeviceGetAttribute(&cus, hipDeviceAttributeMultiprocessorCount, dev);
        if (hipFuncSetAttribute((const void*)mega_fwd, hipFuncAttributeMaxDynamicSharedMemorySize, LDS_BYTES) != hipSuccess) { fprintf(stderr, "kernel_launch: hipFuncSetAttribute failed\n"); grid = -1; return; }
        if (hipOccupancyMaxActiveBlocksPerMultiprocessor(&per_cu, (const void*)mega_fwd, 512, LDS_BYTES) != hipSuccess || per_cu < 1) { fprintf(stderr, "kernel_launch: occupancy query says %d\n", per_cu); per_cu = 1; }
        (void)hipGetLastError();
        grid = cus * per_cu;
    }
    if (grid < 0) return;
    if (hipMemsetAsync((char*)d_ws + 512 * 1024, 0, 512 * 1024, stream) != hipSuccess) { fprintf(stderr, "kernel_launch: memset failed\n"); return; }
    Params p{};
    const float** pp = (const float**)&p;
    for (int i = 0; i < 29; ++i) pp[i] = (const float*)d_in[i];
    p.out = (float*)d_out; p.ws = (unsigned char*)d_ws;
    void* args[] = {&p};
    hipError_t e = hipLaunchCooperativeKernel((const void*)mega_fwd, dim3(grid), dim3(512), args, LDS_BYTES, stream);
    if (e != hipSuccess) fprintf(stderr, "cooperative launch failed: %s (grid %d)\n", hipGetErrorString(e), grid);
}
```
